# Optimizing an MI355X kernel written in HIP

```python
import jax, jax.numpy as jnp
from jax import lax
import numpy as np

D_MODEL = 1024
BATCH = 16
SEQ = 2048
DEPTH = 2

HEAD_DIM = 64
SB_HEADS = 8
NSA_HEADS = 8
NSA_KV_GROUPS = 2
NSA_REP = NSA_HEADS // NSA_KV_GROUPS
NSA_CMP_LEN = 32
NSA_CMP_STRIDE = 16
NSA_CMP_HIDDEN = 256
NSA_SLC_BLOCK = 64
NSA_SLC_TOPK = 16
NSA_WINDOW = 512
Q_BLOCK = 128
SLC_Q_BLOCK = 32
SB_W = SB_HEADS * HEAD_DIM
NSA_Q_W = NSA_HEADS * HEAD_DIM
NSA_KV_W = 6 * NSA_KV_GROUPS * HEAD_DIM
NSA_GATE_W = 3 * NSA_HEADS
MIX0_IN = 3 * SB_W + NSA_Q_W + NSA_KV_W + NSA_GATE_W
MIX0_OUT = SB_W + NSA_Q_W
CONV_WIDTH = 3
D_FF = 2816
N_EXPERTS = 8
TOP_K = 2
EXPERT_D_FF = 2816
MOE_ROW_BLOCK = 512
LN_EPS = 1e-5
DN_ALPHA = (2 * DEPTH) ** 0.25
DN_BETA = (8 * DEPTH) ** -0.25
NEG = -1e30
SEL_FORCE = 1e30

kernel_name = 'hybrid_sb_nsa_conv_moe_block'


def layer_norm(x, g, b):
    xf = x.astype(jnp.float32)
    mu = xf.mean(-1, keepdims=True)
    var = jnp.square(xf - mu).mean(-1, keepdims=True)
    return ((xf - mu) * lax.rsqrt(var + LN_EPS) * g + b).astype(x.dtype)


def masked_softmax(s, mask):
    return jax.nn.softmax(jnp.where(mask, s, NEG), axis=-1) * mask


def stick_breaking_attention(q, k, v):
    S = q.shape[2]
    scale = HEAD_DIM ** -0.5
    outs = []
    for start in range(0, S, Q_BLOCK):
        end = start + Q_BLOCK
        z = jnp.einsum('bhqd,bhkd->bhqk', q[:, :, start:end], k[:, :, :end]).astype(jnp.float32) * scale
        causal = jnp.arange(end)[None, :] < jnp.arange(start, end)[:, None]
        log_fail = jnp.where(causal, jax.nn.log_sigmoid(-z), 0.0)
        later = lax.cumsum(log_fail, axis=3, reverse=True) - log_fail
        w = jnp.where(causal, jnp.exp(jax.nn.log_sigmoid(z) + later), 0.0)
        outs.append(jnp.einsum('bhqk,bhkd->bhqd', w.astype(v.dtype), v[:, :, :end]))
    return jnp.concatenate(outs, axis=2)


def compress_blocks(x, pos, w1, w2):
    B_, G, S, dh = x.shape
    r = NSA_CMP_LEN // NSA_CMP_STRIDE
    n_chunk = S // NSA_CMP_STRIDE
    nc = n_chunk - r + 1
    ch = x.reshape(B_, G, n_chunk, NSA_CMP_STRIDE, dh)
    blocks = jnp.concatenate([ch[:, :, j:j + nc] for j in range(r)], axis=3) + pos
    h = jax.nn.silu(blocks.reshape(B_, G, nc, NSA_CMP_LEN * dh) @ w1)
    return h @ w2


def nsa_attention(q, kv, gates, cmp_pos, cmp_w1, cmp_w2):
    B_, G, R, S, dh = q.shape
    scale = HEAD_DIM ** -0.5
    t = jnp.arange(S)
    k_cmp, v_cmp, k_slc, v_slc, k_win, v_win = kv

    kc = compress_blocks(k_cmp, cmp_pos[0], cmp_w1[0], cmp_w2[0])
    vc = compress_blocks(v_cmp, cmp_pos[1], cmp_w1[1], cmp_w2[1])
    nc = kc.shape[2]
    cmp_start = jnp.arange(nc) * NSA_CMP_STRIDE
    cmp_last = cmp_start + NSA_CMP_LEN - 1
    s_c = jnp.einsum('bgrtd,bgnd->bgrtn', q, kc).astype(jnp.float32) * scale
    p_c = masked_softmax(s_c, cmp_last[None, :] <= t[:, None])
    o_cmp = jnp.einsum('bgrtn,bgnd->bgrtd', p_c.astype(q.dtype), vc)

    ns = S // NSA_SLC_BLOCK
    slc_start = jnp.arange(ns) * NSA_SLC_BLOCK
    overlap = ((cmp_start[:, None] < slc_start[None, :] + NSA_SLC_BLOCK)
               & (cmp_start[:, None] + NSA_CMP_LEN > slc_start[None, :])).astype(jnp.float32)
    imp = jnp.einsum('bgrtn,ns->bgts', p_c, overlap)
    blk = jnp.arange(ns)[None, :]
    cur = (t // NSA_SLC_BLOCK)[:, None]
    valid = slc_start[None, :] <= t[:, None]
    forced = (blk == 0) | (blk == cur) | (blk == cur - 1)
    imp = jnp.where(valid, jnp.where(forced, SEL_FORCE, imp), NEG)
    n_top = min(NSA_SLC_TOPK, ns)
    _, sel = lax.top_k(imp, n_top)

    ksb = k_slc.reshape(B_, G, ns, NSA_SLC_BLOCK, dh)
    vsb = v_slc.reshape(B_, G, ns, NSA_SLC_BLOCK, dh)
    nq = S // SLC_Q_BLOCK
    bi = jnp.arange(B_)[:, None, None, None]
    gi = jnp.arange(G)[None, :, None, None]
    n_keys = n_top * NSA_SLC_BLOCK

    def slc_block(args):
        qc, sc, tc = args
        kg = ksb[bi, gi, sc].reshape(B_, G, SLC_Q_BLOCK, n_keys, dh)
        vg = vsb[bi, gi, sc].reshape(B_, G, SLC_Q_BLOCK, n_keys, dh)
        kpos = (sc[..., None] * NSA_SLC_BLOCK + jnp.arange(NSA_SLC_BLOCK)).reshape(B_, G, SLC_Q_BLOCK, n_keys)
        s = jnp.einsum('bgrqd,bgqkd->bgrqk', qc, kg).astype(jnp.float32) * scale
        p = masked_softmax(s, (kpos <= tc[:, None])[:, :, None])
        return jnp.einsum('bgrqk,bgqkd->bgrqd', p.astype(qc.dtype), vg)

    q_ch = jnp.moveaxis(q.reshape(B_, G, R, nq, SLC_Q_BLOCK, dh), 3, 0)
    sel_ch = jnp.moveaxis(sel.reshape(B_, G, nq, SLC_Q_BLOCK, n_top), 2, 0)
    o_slc = lax.map(slc_block, (q_ch, sel_ch, t.reshape(nq, SLC_Q_BLOCK)))
    o_slc = jnp.moveaxis(o_slc, 0, 3).reshape(B_, G, R, S, dh)

    span = NSA_WINDOW + Q_BLOCK
    pad = ((0, 0), (0, 0), (NSA_WINDOW, 0), (0, 0))
    kp = jnp.pad(k_win, pad)
    vp = jnp.pad(v_win, pad)

    def win_block(i):
        start = i * Q_BLOCK
        qb = lax.dynamic_slice_in_dim(q, start, Q_BLOCK, axis=3)
        kb = lax.dynamic_slice_in_dim(kp, start, span, axis=2)
        vb = lax.dynamic_slice_in_dim(vp, start, span, axis=2)
        tq = start + jnp.arange(Q_BLOCK)
        kpos = start - NSA_WINDOW + jnp.arange(span)
        diff = tq[:, None] - kpos[None, :]
        mask = (diff >= 0) & (diff < NSA_WINDOW) & (kpos[None, :] >= 0)
        s = jnp.einsum('bgrqd,bgkd->bgrqk', qb, kb).astype(jnp.float32) * scale
        p = masked_softmax(s, mask)
        return jnp.einsum('bgrqk,bgkd->bgrqd', p.astype(q.dtype), vb)

    o_win = lax.map(win_block, jnp.arange(S // Q_BLOCK))
    o_win = jnp.moveaxis(o_win, 0, 3).reshape(B_, G, R, S, dh)

    g = jax.nn.sigmoid(gates)
    return g[..., 0:1] * o_cmp + g[..., 1:2] * o_slc + g[..., 2:3] * o_win


def parallel_attention_mixer(h, w_in, cmp_pos, cmp_w1, cmp_w2, w_out):
    B_, S, _ = h.shape
    proj = h @ w_in
    sizes = [SB_W, SB_W, SB_W, NSA_Q_W, NSA_KV_W]
    cuts = [int(v) for v in np.cumsum(sizes)]
    sb_q, sb_k, sb_v, nsa_q, nsa_kv, nsa_g = jnp.split(proj, cuts, axis=-1)
    heads = lambda a: a.reshape(B_, S, SB_HEADS, HEAD_DIM).transpose(0, 2, 1, 3)
    o_sb = stick_breaking_attention(heads(sb_q), heads(sb_k), heads(sb_v))
    o_sb = o_sb.transpose(0, 2, 1, 3).reshape(B_, S, SB_W)
    q = nsa_q.reshape(B_, S, NSA_KV_GROUPS, NSA_REP, HEAD_DIM).transpose(0, 2, 3, 1, 4)
    kv = nsa_kv.reshape(B_, S, 6, NSA_KV_GROUPS, HEAD_DIM).transpose(2, 0, 3, 1, 4)
    gates = nsa_g.reshape(B_, S, NSA_KV_GROUPS, NSA_REP, 3).transpose(0, 2, 3, 1, 4)
    o_nsa = nsa_attention(q, kv, gates, cmp_pos, cmp_w1, cmp_w2)
    o_nsa = o_nsa.transpose(0, 3, 1, 2, 4).reshape(B_, S, NSA_Q_W)
    return jnp.concatenate([o_sb, o_nsa], axis=-1) @ w_out


def short_conv_mixer(h, w_in, conv_taps, w_out):
    gate_b, gate_c, u = jnp.split(h @ w_in, 3, axis=-1)
    z = gate_c * u
    zc = lax.conv_general_dilated(z, conv_taps[:, None, :], window_strides=(1,),
                                  padding=[(CONV_WIDTH - 1, 0)],
                                  dimension_numbers=('NWC', 'WIO', 'NWC'),
                                  feature_group_count=z.shape[-1])
    return (gate_b * zc) @ w_out


def swiglu(h, w1, w3, w2):
    return (jax.nn.silu(h @ w1) * (h @ w3)) @ w2


def moe_swiglu(h, w_router, b_router, w1, w3, w2):
    B_, S, D = h.shape
    T = B_ * S
    xf = h.reshape(T, D)
    logits = (xf @ w_router + b_router).astype(jnp.float32)
    top_val, top_idx = lax.top_k(logits, TOP_K)
    gate = jax.nn.softmax(top_val, axis=-1)
    n_assign = T * TOP_K
    e_flat = top_idx.reshape(-1)
    tok_flat = jnp.arange(n_assign) // TOP_K
    g_flat = gate.reshape(-1)
    order = jnp.argsort(e_flat)
    e_sorted = e_flat[order]
    counts = jnp.bincount(e_flat, length=N_EXPERTS)
    starts = jnp.cumsum(counts) - counts
    padded = (counts + MOE_ROW_BLOCK - 1) // MOE_ROW_BLOCK * MOE_ROW_BLOCK
    pends = jnp.cumsum(padded)
    pstarts = pends - padded
    dest = pstarts[e_sorted] + (jnp.arange(n_assign) - starts[e_sorted])
    n_blocks = -(-n_assign // MOE_ROW_BLOCK) + N_EXPERTS
    rows = n_blocks * MOE_ROW_BLOCK
    buf = jnp.zeros((rows, D), h.dtype).at[dest].set(xf[tok_flat[order]])
    row_tok = jnp.zeros((rows,), jnp.int32).at[dest].set(tok_flat[order].astype(jnp.int32))
    row_w = jnp.zeros((rows,), jnp.float32).at[dest].set(g_flat[order])
    blk_e = jnp.minimum(jnp.searchsorted(pends, jnp.arange(n_blocks) * MOE_ROW_BLOCK, side='right'), N_EXPERTS - 1)

    def expert_rows(args):
        xb, e = args
        return swiglu(xb, w1[e], w3[e], w2[e])

    yb = lax.map(expert_rows, (buf.reshape(n_blocks, MOE_ROW_BLOCK, D), blk_e))
    y = yb.reshape(rows, D) * row_w[:, None].astype(yb.dtype)
    return jax.ops.segment_sum(y, row_tok, num_segments=T).reshape(B_, S, D)


def setup_inputs(seed: int = 0) -> dict:
    key = jax.random.key(seed)
    ks = iter(jax.random.split(key, 40))
    nrm = lambda shape, scale: jax.random.normal(next(ks), shape, jnp.float32) * scale
    n_even = (DEPTH + 1) // 2
    n_odd = DEPTH // 2
    D = D_MODEL
    return {
        'x': nrm((BATCH, SEQ, D), 1.0),
        'c': nrm((BATCH, D), 1.0),
        'ada_w': nrm((DEPTH, D, 6 * D), 0.02),
        'ada_b': nrm((DEPTH, 6 * D), 0.02),
        'ln_g': 1.0 + nrm((DEPTH, 2, D), 0.02),
        'ln_b': nrm((DEPTH, 2, D), 0.02),
        'mix_w_in': nrm((n_even, D, MIX0_IN), D ** -0.5),
        'cmp_pos': nrm((n_even, 2, NSA_CMP_LEN, HEAD_DIM), 0.1),
        'cmp_w1': nrm((n_even, 2, NSA_CMP_LEN * HEAD_DIM, NSA_CMP_HIDDEN), (NSA_CMP_LEN * HEAD_DIM) ** -0.5),
        'cmp_w2': nrm((n_even, 2, NSA_CMP_HIDDEN, HEAD_DIM), NSA_CMP_HIDDEN ** -0.5),
        'mix_w_out': nrm((n_even, MIX0_OUT, D), MIX0_OUT ** -0.5 * DN_BETA),
        'ffn_w1': nrm((n_even, D, D_FF), D ** -0.5),
        'ffn_w3': nrm((n_even, D, D_FF), D ** -0.5),
        'ffn_w2': nrm((n_even, D_FF, D), D_FF ** -0.5 * DN_BETA),
        'conv_w_in': nrm((n_odd, D, 3 * D), D ** -0.5),
        'conv_taps': nrm((n_odd, CONV_WIDTH, D), CONV_WIDTH ** -0.5),
        'conv_w_out': nrm((n_odd, D, D), D ** -0.5 * DN_BETA),
        'router_w': nrm((n_odd, D, N_EXPERTS), D ** -0.5),
        'router_b': nrm((n_odd, N_EXPERTS), 0.01),
        'exp_w1': nrm((n_odd, N_EXPERTS, D, EXPERT_D_FF), D ** -0.5),
        'exp_w3': nrm((n_odd, N_EXPERTS, D, EXPERT_D_FF), D ** -0.5),
        'exp_w2': nrm((n_odd, N_EXPERTS, EXPERT_D_FF, D), EXPERT_D_FF ** -0.5 * DN_BETA),
    }


def reference(x, c, ada_w, ada_b, ln_g, ln_b, mix_w_in, cmp_pos, cmp_w1, cmp_w2, mix_w_out,
              ffn_w1, ffn_w3, ffn_w2, conv_w_in, conv_taps, conv_w_out, router_w, router_b,
              exp_w1, exp_w3, exp_w2):
    cond = jax.nn.silu(c)
    for i in range(DEPTH):
        j = i // 2
        mod = cond @ ada_w[i] + ada_b[i]
        sh1, sc1, g1, sh2, sc2, g2 = jnp.split(mod[:, None, :], 6, axis=-1)
        h = x * (1 + sc1) + sh1
        if i % 2 == 0:
            y = parallel_attention_mixer(h, mix_w_in[j], cmp_pos[j], cmp_w1[j], cmp_w2[j], mix_w_out[j])
        else:
            y = short_conv_mixer(h, conv_w_in[j], conv_taps[j], conv_w_out[j])
        x = layer_norm(DN_ALPHA * x + (1 + g1) * y, ln_g[i, 0], ln_b[i, 0])
        h = x * (1 + sc2) + sh2
        if i % 2 == 0:
            y = swiglu(h, ffn_w1[j], ffn_w3[j], ffn_w2[j])
        else:
            y = moe_swiglu(h, router_w[j], router_b[j], exp_w1[j], exp_w3[j], exp_w2[j])
        x = layer_norm(DN_ALPHA * x + (1 + g2) * y, ln_g[i, 1], ln_b[i, 1])
    return x
```

```cpp
#include <hip/hip_runtime.h>
#include <cstdio>
#include <cstdint>

#define LAS __attribute__((address_space(3)))
#define GAS __attribute__((address_space(1)))
typedef unsigned short bf16_t;
typedef short bf16x8 __attribute__((ext_vector_type(8)));
typedef short s16x4 __attribute__((ext_vector_type(4)));
typedef float f32x4 __attribute__((ext_vector_type(4)));
typedef float f32x2 __attribute__((ext_vector_type(2)));
typedef float f32x16 __attribute__((ext_vector_type(16)));
typedef unsigned u32x4 __attribute__((ext_vector_type(4)));
typedef unsigned u32x2 __attribute__((ext_vector_type(2)));

constexpr int BATCH = 16, SEQ = 2048, DM = 1024, MTOK = BATCH * SEQ;
constexpr int NPROJ = 2816;
constexpr int MIXN = 2840, MIXNP = 3072;
constexpr int DFF = 2816, NEXP = 8;
constexpr int MOE_ROWS = 34816;
constexpr float LN_EPS = 1e-5f;
constexpr float DN_ALPHA = 1.4142135623730951f;
constexpr float LOG2E = 1.4426950408889634f;
constexpr float QSCALE = 0.125f * LOG2E;

constexpr size_t MiB = 1u << 20;
constexpr size_t WS_CTL = 0, CTL_BYTES = 1 * MiB;
constexpr size_t WS_SMALL = 1 * MiB;
constexpr size_t WS_MOD = WS_SMALL;
constexpr size_t WS_CBIAS = WS_MOD + 786432;
constexpr size_t WS_ASG = WS_CBIAS + 4096;
constexpr size_t WS_AGATE = WS_ASG + 2 * MTOK * 4;
constexpr size_t WS_ROWTOK = WS_AGATE + 2 * MTOK * 4;
constexpr size_t WS_ROWGATE = WS_ROWTOK + 2 * MOE_ROWS * 4;
constexpr size_t WS_SMALL_END = WS_ROWGATE + 2 * MOE_ROWS * 4;
static_assert(WS_SMALL_END <= 8 * MiB, "small tables");
constexpr size_t WS_W = 8 * MiB;
constexpr size_t W_MIX = WS_W;
constexpr size_t W_OUT = W_MIX + (size_t)MIXNP * DM * 2;
constexpr size_t W_F13 = W_OUT + (size_t)DM * DM * 2;
constexpr size_t W_F2 = W_F13 + (size_t)2 * DFF * DM * 2;
constexpr size_t W_CIN = W_F2 + (size_t)DM * DFF * 2;
constexpr size_t W_COUT = W_CIN + (size_t)3 * DM * DM * 2;
constexpr size_t W_E13 = W_COUT + (size_t)DM * DM * 2;
constexpr size_t W_E2 = W_E13 + (size_t)NEXP * 2 * DFF * DM * 2;
constexpr size_t W_C1 = W_E2 + (size_t)NEXP * DM * DFF * 2;
constexpr size_t W_C2 = W_C1 + (size_t)2 * 256 * 2048 * 2;
constexpr size_t WS_W_END = W_C2 + (size_t)2 * 256 * 256 * 2;
constexpr size_t WS_R1 = 176 * MiB;
constexpr size_t WS_R2 = 240 * MiB;
constexpr size_t WS_R3 = 416 * MiB;
constexpr size_t WS_END = 480 * MiB;
static_assert(WS_W_END <= WS_R1, "weights fit");
static_assert((size_t)MOE_ROWS * DFF * 2 <= WS_R3 - WS_R1, "MoE activation chunk fits R1+R2");
constexpr size_t R2_Q = WS_R2;
constexpr size_t R2_SBK = WS_R2 + 64 * MiB;
constexpr size_t R2_SBV = WS_R2 + 96 * MiB;
constexpr size_t R2_NSA = WS_R2 + 128 * MiB;
constexpr size_t R3_KC = WS_R3;
constexpr size_t R3_KCPAD = R3_KC + 16 * MiB;
constexpr size_t R3_GATE = R3_KC + 17 * MiB;
constexpr size_t R3_HID = R3_KC + 21 * MiB;
constexpr size_t R3_KCV = R3_KC + 25 * MiB;

constexpr int CW_BAR = 4096;
constexpr int CW_WQ = 8192;
constexpr int CW_ECNT = 9216;
constexpr int CW_TEND = 12288;

constexpr int LDS_BYTES = 147456;
constexpr int MISC_OFF = 131072 + 320;

__device__ __forceinline__ unsigned cvt_pk_bf16(float lo, float hi) { unsigned r; asm volatile("v_cvt_pk_bf16_f32 %0, %1, %2" : "=v"(r) : "v"(lo), "v"(hi)); return r; }
__device__ __forceinline__ float bf2f(bf16_t v) { return __uint_as_float((unsigned)v << 16); }
__device__ __forceinline__ float bflo(unsigned w) { return __uint_as_float(w << 16); }
__device__ __forceinline__ float bfhi(unsigned w) { return __uint_as_float(w & 0xffff0000u); }
__device__ __forceinline__ float fast_exp2(float x) { return __builtin_amdgcn_exp2f(x); }
__device__ __forceinline__ float fast_log2(float x) { return __builtin_amdgcn_logf(x); }
__device__ __forceinline__ float fast_rcp(float x) { return __builtin_amdgcn_rcpf(x); }
__device__ __forceinline__ float silu_f(float a) { return a * fast_rcp(1.0f + fast_exp2(-a * LOG2E)); }
__device__ __forceinline__ float sigmoid_f(float a) { return fast_rcp(1.0f + fast_exp2(-a * LOG2E)); }
__device__ __forceinline__ float wave_sum(float v) {
#pragma unroll
    for (int o = 1; o < 64; o <<= 1) v += __shfl_xor(v, o);
    return v;
}

__device__ __forceinline__ int opaque_tid() { int t = threadIdx.x; asm volatile("" : "+v"(t)); return t; }

namespace pg8 {
constexpr int BM = 256, BK = 64, HALF = 128, HTB = HALF * BK * 2, STAGE_BYTES = 8 * HTB;
__host__ __device__ __forceinline__ int lds_byte(int r, int c) { const int st = (r >> 4) * 2 + (c >> 5), rr = r & 15, cc = c & 31, ob = rr * 64 + cc * 2; return st * 1024 + (ob ^ (((ob >> 9) & 1) << 5)); }
__host__ __device__ __forceinline__ void stage_rc(int b, int& R, int& C) { const int st = b / 1024, sb = b % 1024, swz = sb ^ (((sb >> 9) & 1) << 5); R = (st >> 1) * 16 + swz / 64; C = (st & 1) * 32 + (swz % 64) / 2; }
__host__ __device__ __forceinline__ int perm32(int rho) { const int n = rho >> 4, i = rho & 15; return 8 * (i >> 2) + 4 * n + (i & 3); }

struct Unit { int pm, pn, koff, nt; };
struct Gemm { const bf16_t* A; const bf16_t* Bt; int lda; int K; const int* rowidx; int ldb; };

template <class Epi, class Sched, bool ALIGN_EPI, bool GATHER>
__device__ __forceinline__ void gemm_phase(LAS unsigned char* lds, const Gemm g, const Sched& S, const Epi& E) {
    const int tid = opaque_tid(), wid = __builtin_amdgcn_readfirstlane(tid >> 6), lane = tid & 63, wr = wid >> 2, wc = wid & 3, fr = lane & 15, fq = lane >> 4;
    const int K = g.K, nt = K / BK, lda = g.lda, ldb = g.ldb ? g.ldb : g.K;
    unsigned vA[2][2], vAn[2][2], vB[2]; int rA[2], cA2[2];
#pragma unroll
    for (int i = 0; i < 2; ++i) { int R, C; stage_rc(tid * 16 + i * 8192, R, C); const int Rb = Epi::PERM ? ((R & ~31) + perm32(R & 31)) : R;
        rA[i] = R; cA2[i] = C * 2;
        vA[0][i] = (unsigned)(R * lda + C) * 2u; vA[1][i] = (unsigned)((R + HALF) * lda + C) * 2u; vB[i] = (unsigned)(Rb * ldb + C) * 2u;
        vAn[0][i] = vA[0][i]; vAn[1][i] = vA[1][i]; }
    const size_t kstep = (size_t)(BK * 2);
    const size_t hstepB = (size_t)HALF * ldb * 2;
    const size_t tstepB = 2 * hstepB;
    const size_t tstepA = (size_t)BM * lda * 2;
    const unsigned ldsw = (unsigned)wid * 1024u;
    const int aoff = lds_byte(wr * 64 + fr, fq * 8), boff = lds_byte(wc * 32 + fr, fq * 8);
#define PG8_SA(b, h) (((b) * 2 + (h)) * HTB)
#define PG8_SB(b, h) ((4 + (b) * 2 + (h)) * HTB)
#define PG8_STAGE2(bufoff, gbase, o0, o1) do { \
        __builtin_amdgcn_global_load_lds((const unsigned*)((const char*)(gbase) + (o0)), (LAS unsigned*)(lds + (bufoff) + ldsw), 16, 0, 0); \
        __builtin_amdgcn_global_load_lds((const unsigned*)((const char*)(gbase) + (o1)), (LAS unsigned*)(lds + (bufoff) + ldsw + 8192), 16, 0, 0); } while (0)
#define PG8_STB(bufoff, gbase) PG8_STAGE2(bufoff, gbase, vB[0], vB[1])
#define PG8_STA(bufoff, gbase, h) PG8_STAGE2(bufoff, gbase, vA[h][0], vA[h][1])
#define PG8_LDA(dst, b, h) do { _Pragma("unroll") for (int m = 0; m < 4; ++m) _Pragma("unroll") for (int k = 0; k < 2; ++k) dst[m][k] = *(const LAS bf16x8*)(lds + PG8_SA(b, h) + aoff + m * 2048 + k * 1024); } while (0)
#define PG8_LDB(dst, b, h) do { _Pragma("unroll") for (int n = 0; n < 2; ++n) _Pragma("unroll") for (int k = 0; k < 2; ++k) dst[n][k] = *(const LAS bf16x8*)(lds + PG8_SB(b, h) + boff + n * 2048 + k * 1024); } while (0)
#define PG8_MMA(ai, bj, At, Bt) do { __builtin_amdgcn_s_setprio(1); _Pragma("unroll") for (int m = 0; m < 4; ++m) _Pragma("unroll") for (int n = 0; n < 2; ++n) _Pragma("unroll") for (int k = 0; k < 2; ++k) \
        acc[ai][bj][m][n] = __builtin_amdgcn_mfma_f32_16x16x32_bf16(Bt[n][k], At[m][k], acc[ai][bj][m][n], 0, 0, 0); __builtin_amdgcn_s_setprio(0); } while (0)
#define PG8_WAIT_V(n) asm volatile("s_waitcnt vmcnt(" #n ")" ::: "memory")
#define PG8_WAIT_L(n) asm volatile("s_waitcnt lgkmcnt(" #n ")" ::: "memory")
#define PG8_BAR __builtin_amdgcn_s_barrier()
#define PG8_SCHED __builtin_amdgcn_sched_barrier(0)
#define PG8_GIDX(dst, u) do { if constexpr (GATHER) { _Pragma("unroll") for (int h = 0; h < 2; ++h) _Pragma("unroll") for (int i = 0; i < 2; ++i) { \
        int tk = g.rowidx[(u).pm * BM + h * HALF + rA[i]]; tk = tk < 0 ? 0 : tk; dst[h][i] = (unsigned)tk * (unsigned)(lda * 2) + (unsigned)cA2[i]; } } } while (0)
    Unit cur, nxt; int ui = 0;
    if (!S.next(0, cur)) return;
    f32x4 acc[2][2][4][2];
#pragma unroll
    for (int a = 0; a < 2; ++a)
#pragma unroll
        for (int b = 0; b < 2; ++b)
#pragma unroll
            for (int m = 0; m < 4; ++m)
#pragma unroll
                for (int n = 0; n < 2; ++n) acc[a][b][m][n] = (f32x4){0.f, 0.f, 0.f, 0.f};
    bf16x8 At[4][2], B0[2][2], B1[2][2];
    const char* cA = GATHER ? (const char*)g.A : (const char*)g.A + (size_t)cur.pm * tstepA + cur.koff; const char* cB = (const char*)g.Bt + (size_t)cur.pn * tstepB + cur.koff;
    PG8_GIDX(vA, cur);
    PG8_STB(PG8_SB(0, 0), cB); PG8_STB(PG8_SB(0, 1), cB + hstepB); PG8_STA(PG8_SA(0, 0), cA, 0); PG8_STA(PG8_SA(0, 1), cA, 1);
    if (wr == 1) PG8_BAR;
    PG8_WAIT_V(2); PG8_BAR;
    PG8_STB(PG8_SB(1, 0), cB + kstep); PG8_STA(PG8_SA(1, 0), cA + kstep, 0); PG8_STB(PG8_SB(1, 1), cB + hstepB + kstep);
    PG8_WAIT_V(6); PG8_BAR;
    for (;;) {
        const bool has_next = S.next(ui + 1, nxt);
        const char* nA = GATHER ? cA : (has_next ? (const char*)g.A + (size_t)nxt.pm * tstepA + nxt.koff : cA); const char* nB = has_next ? (const char*)g.Bt + (size_t)nxt.pn * tstepB + nxt.koff : cB;
        if constexpr (GATHER) { if (has_next) { PG8_GIDX(vAn, nxt); } else {
#pragma unroll
            for (int h = 0; h < 2; ++h)
#pragma unroll
                for (int i = 0; i < 2; ++i) vAn[h][i] = vA[h][i]; } }
        const int ntu = cur.nt > 0 ? cur.nt : nt;
        for (int t = 0; t < ntu; t += 2) {
            const bool last = (t == ntu - 2);
            const char* a1 = cA + (size_t)(t + 1) * kstep;
            const char* a2 = last ? nA : cA + (size_t)(t + 2) * kstep; const char* b2 = last ? nB : cB + (size_t)(t + 2) * kstep;
            const char* a3 = a2 + kstep; const char* b3 = b2 + kstep;
            PG8_LDB(B0, 0, 0); PG8_LDB(B1, 0, 1); PG8_SCHED; PG8_LDA(At, 0, 0); PG8_STA(PG8_SA(1, 1), a1, 1);
            if constexpr (GATHER) { if (last) {
#pragma unroll
                for (int h = 0; h < 2; ++h)
#pragma unroll
                    for (int i = 0; i < 2; ++i) vA[h][i] = vAn[h][i]; } }
            PG8_WAIT_V(8); PG8_WAIT_L(0); PG8_BAR; PG8_MMA(0, 0, At, B0); PG8_MMA(0, 1, At, B1); PG8_BAR; PG8_SCHED;
            PG8_LDA(At, 0, 1); PG8_STB(PG8_SB(0, 0), b2); PG8_STB(PG8_SB(0, 1), b2 + hstepB); PG8_STA(PG8_SA(0, 0), a2, 0);
            PG8_WAIT_V(8); PG8_WAIT_L(0); PG8_BAR; PG8_MMA(1, 0, At, B0); PG8_MMA(1, 1, At, B1); PG8_BAR; PG8_SCHED;
            PG8_LDB(B0, 1, 0); PG8_LDB(B1, 1, 1); PG8_SCHED; PG8_LDA(At, 1, 0); PG8_STA(PG8_SA(0, 1), a2, 1);
            PG8_WAIT_V(8); PG8_WAIT_L(0); PG8_BAR; PG8_MMA(0, 0, At, B0); PG8_MMA(0, 1, At, B1); PG8_BAR; PG8_SCHED;
            PG8_LDA(At, 1, 1); PG8_STB(PG8_SB(1, 0), b3); PG8_STB(PG8_SB(1, 1), b3 + hstepB); PG8_STA(PG8_SA(1, 0), a3, 0);
            PG8_WAIT_V(8); PG8_WAIT_L(0); PG8_BAR; PG8_MMA(1, 0, At, B0); PG8_MMA(1, 1, At, B1); PG8_BAR; PG8_SCHED;
        }
        if constexpr (ALIGN_EPI) { if (wr == 0) PG8_BAR; }
        E(acc, cur, wr, wc, fr, fq);
        if (!has_next) break;
#pragma unroll
        for (int a = 0; a < 2; ++a)
#pragma unroll
            for (int b = 0; b < 2; ++b)
#pragma unroll
                for (int m = 0; m < 4; ++m)
#pragma unroll
                    for (int n = 0; n < 2; ++n) acc[a][b][m][n] = (f32x4){0.f, 0.f, 0.f, 0.f};
        cur = nxt; cA = nA; cB = nB; ++ui;
        if constexpr (ALIGN_EPI) { if (wr == 1) PG8_BAR; }
    }
    PG8_WAIT_V(0);
    if constexpr (!ALIGN_EPI) { if (wr == 0) PG8_BAR; }
    PG8_BAR;
#undef PG8_SA
#undef PG8_SB
#undef PG8_STAGE2
#undef PG8_STB
#undef PG8_STA
#undef PG8_LDA
#undef PG8_LDB
#undef PG8_MMA
#undef PG8_WAIT_V
#undef PG8_WAIT_L
#undef PG8_BAR
#undef PG8_SCHED
#undef PG8_GIDX
}
}

#define XB_TMO      128
#define XB_XCNT(j)  (256  + 64 * (j))
#define XB_XSUB(j)  (1280 + 64 * (j))
#define XB_XGEN(j)  (2304 + 64 * (j))
#define XB_TOP      3328
#define XB_TOPGEN   3392
#define XCD_BAR_WORDS 3456
#define XB_SPIN_CAP (1u << 18)
__device__ __forceinline__ unsigned xb_ld(unsigned* p)              { return __hip_atomic_load(p, __ATOMIC_RELAXED, __HIP_MEMORY_SCOPE_AGENT); }
__device__ __forceinline__ unsigned xb_add(unsigned* p, unsigned v) { return __hip_atomic_fetch_add(p, v, __ATOMIC_RELAXED, __HIP_MEMORY_SCOPE_AGENT); }
__device__ __forceinline__ unsigned xb_xcc_id() { return (unsigned)__builtin_amdgcn_s_getreg((3 << 11) | 20) & 0xFu; }
#define XB_SPIN(cond, bar) do { unsigned _sp = 0; while (cond) { __builtin_amdgcn_s_sleep(1); \
    if ((++_sp & 255u) == 0u) { if (xb_ld(&(bar)[XB_TMO])) break; if (_sp > XB_SPIN_CAP) { atomicAdd(&(bar)[XB_TMO], 1u); break; } } } } while (0)
struct XcdBarrier { unsigned* bar; unsigned x; volatile LAS unsigned* st; };
__device__ __forceinline__ XcdBarrier xcd_barrier_post(unsigned* bar, volatile LAS unsigned* st) {
    XcdBarrier b; b.bar = bar; b.x = xb_xcc_id(); b.st = st;
    if (threadIdx.x == 0) (void)xb_add(&bar[XB_XCNT(b.x)], 1u);
    return b;
}
__device__ __forceinline__ void xcd_barrier_complete(unsigned* bar, unsigned x, unsigned& nloc, unsigned& nx) {
    const unsigned G = gridDim.x * gridDim.y * gridDim.z;
    unsigned sum, cnt, mine, sp = 0u;
    for (;;) {
        sum = 0u; cnt = 0u; mine = 0u;
#pragma unroll
        for (unsigned j = 0; j < 16; ++j) { const unsigned c = xb_ld(&bar[XB_XCNT(j)]); sum += c; cnt += (c > 0u) ? 1u : 0u; mine = (j == x) ? c : mine; }
        if (sum == G) break;
        __builtin_amdgcn_s_sleep(1);
        if ((++sp & 255u) == 0u) { if (xb_ld(&bar[XB_TMO])) break; if (sp > XB_SPIN_CAP) { atomicAdd(&bar[XB_TMO], 1u); break; } }
    }
    nloc = mine > 0u ? mine : 1u; nx = cnt > 0u ? cnt : 1u;
}
__device__ __forceinline__ void xcd_barrier(const XcdBarrier& b) {
    asm volatile("s_waitcnt vmcnt(0)" ::: "memory");
    __syncthreads();
    if (threadIdx.x == 0) {
        unsigned* bar = b.bar;
        __builtin_amdgcn_s_waitcnt(0);
        unsigned nloc = b.st[0], nx = b.st[1];
        if (nloc == 0u) { xcd_barrier_complete(bar, b.x, nloc, nx); b.st[0] = nloc; b.st[1] = nx; }
        const unsigned old = xb_add(&bar[XB_XSUB(b.x)], 1u);
        const unsigned gen = old / nloc;
        if (old + 1u == (gen + 1u) * nloc) {
            __builtin_amdgcn_fence(__ATOMIC_RELEASE, "agent");
            asm volatile("s_waitcnt vmcnt(0)" ::: "memory");
            const unsigned og = xb_add(&bar[XB_TOP], 1u);
            const unsigned tg = og / nx;
            if (og + 1u == (tg + 1u) * nx) xb_add(&bar[XB_TOPGEN], 1u);
            else XB_SPIN(xb_ld(&bar[XB_TOPGEN]) == tg, bar);
            __builtin_amdgcn_fence(__ATOMIC_ACQUIRE, "agent");
            xb_add(&bar[XB_XGEN(b.x)], 1u);
            asm volatile("s_waitcnt vmcnt(0)" ::: "memory");
        } else {
            XB_SPIN(xb_ld(&bar[XB_XGEN(b.x)]) == gen, bar);
            __builtin_amdgcn_fence(__ATOMIC_ACQUIRE, "agent");
            asm volatile("s_waitcnt vmcnt(0)" ::: "memory");
        }
    }
    __syncthreads();
}

struct GridOrder {
    int nM, nN, nwg, G, c;
    __device__ __forceinline__ void init(int nM_, int nN_, int G_, int c_) { nM = nM_; nN = nN_; nwg = nM_ * nN_; G = G_; c = c_; }
    __device__ __forceinline__ bool next(int i, pg8::Unit& u) const {
        int L = i * G + c; if (L >= nwg) return false;
        const int nig = 8 * nN, gid = L / nig, fm = gid * 8, gsz = (nM - fm) < 8 ? (nM - fm) : 8, w = L % nig;
        u.pm = fm + (w % gsz); u.pn = w / gsz; u.koff = 0; u.nt = 0; return true;
    }
};
struct CmpOrder {
    int G, c;
    __device__ __forceinline__ bool next(int i, pg8::Unit& u) const { const int L = i * G + c; if (L >= 32) return false; u.pm = L; u.pn = L >> 4; u.koff = 0; u.nt = 0; return true; }
};
struct MoeOrder {
    int G, c, NJ, ntiles, nsplit; const LAS unsigned* tend;
    __device__ __forceinline__ bool next(int i, pg8::Unit& u) const {
        int L = i * G + c; const int nwg = ntiles * NJ; int rt, j;
        if (L < nwg) { const int nig = 8 * NJ, gid = L / nig, fm = gid * 8, gsz = (ntiles - fm) < 8 ? (ntiles - fm) : 8, w = L % nig; rt = fm + (w % gsz); j = w / gsz; u.koff = 0; u.nt = 0; }
        else { L -= nwg; if (L >= nsplit * 44) return false; const int ch = L % 11, rest = L / 11; j = rest & 3; rt = ntiles + (rest >> 2); u.koff = ch * 512; u.nt = 4; }
        int e = 0;
#pragma unroll
        for (int q = 0; q < 7; ++q) e += (rt >= (int)tend[q]) ? 1 : 0;
        u.pm = rt; u.pn = __builtin_amdgcn_readfirstlane(e) * NJ + j; return true;
    }
};

typedef const f32x4 (&AccRef)[2][2][4][2];
__device__ __forceinline__ u32x4 pack8(f32x4 a, f32x4 b) { u32x4 w; w.x = cvt_pk_bf16(a[0], a[1]); w.y = cvt_pk_bf16(a[2], a[3]); w.z = cvt_pk_bf16(b[0], b[1]); w.w = cvt_pk_bf16(b[2], b[3]); return w; }

template <int ACT> struct EpiPlain {
    static constexpr bool PERM = true;
    bf16_t* O; int ldc; const float* bias; int ncols_valid; int pn_mod;
    __device__ __forceinline__ void operator()(AccRef acc, const pg8::Unit& u, int wr, int wc, int fr, int fq) const {
        const int row0 = u.pm * 256 + wr * 64 + fr; const int colt = (u.pn % pn_mod) * 256;
#pragma unroll
        for (int bj = 0; bj < 2; ++bj) { const int col = colt + bj * 128 + wc * 32 + 8 * fq; if (col >= ncols_valid) continue;
            f32x4 b0 = (f32x4){0.f, 0.f, 0.f, 0.f}, b1 = b0;
            if (ACT == 1) { const float* bp = bias + u.pn * 256 + bj * 128 + wc * 32 + 8 * fq; b0 = *(const f32x4*)bp; b1 = *(const f32x4*)(bp + 4); }
#pragma unroll
            for (int ai = 0; ai < 2; ++ai)
#pragma unroll
                for (int m = 0; m < 4; ++m) { f32x4 v0 = acc[ai][bj][m][0], v1 = acc[ai][bj][m][1];
                    if (ACT == 1) { v0 += b0; v1 += b1;
#pragma unroll
                        for (int e = 0; e < 4; ++e) { v0[e] = silu_f(v0[e]); v1[e] = silu_f(v1[e]); } }
                    *(u32x4*)(O + (size_t)(row0 + ai * 128 + m * 16) * ldc + col) = pack8(v0, v1); } }
    }
};
struct EpiMix {
    static constexpr bool PERM = true;
    bf16_t* Q; unsigned char* SBK; unsigned char* SBV; unsigned char* NSAI; bf16_t* KC; float* GATE;
    __device__ __forceinline__ void operator()(AccRef acc, const pg8::Unit& u, int wr, int wc, int fr, int fq) const {
        const int row = u.pm * 256 + wr * 64 + fr; const int pn = u.pn;
        const int b = row >> 11, t = row & 2047, tile = t >> 6, key = t & 63;
        const float sc = (pn < 2 || pn == 6 || pn == 7) ? QSCALE : 1.0f;
#pragma unroll
        for (int bj = 0; bj < 2; ++bj) { const int cc = bj * 128 + wc * 32 + 8 * fq;
            unsigned char* base; int sm, sa = 16384; bool gate = false, skip = false;
            if (pn == 11) { gate = true; skip = cc >= 24; base = (unsigned char*)(GATE + (size_t)row * 32 + cc); sm = 2048; }
            else if (pn == 8) { const int which = cc >> 7, g = (cc >> 6) & 1, d = cc & 63; base = (unsigned char*)(KC + ((((size_t)(which * 16 + b) * 2 + g) * 2048 + t) * 64 + d)); sm = 2048; }
            else if (pn < 2 || pn == 6 || pn == 7) { const int col = (pn < 2 ? pn * 256 : 512 + (pn - 6) * 256) + cc; base = (unsigned char*)(Q + (size_t)row * DM + col); sm = 32768; sa = 262144; }
            else if (pn < 6) { const int ci = (pn & 1) * 256 + cc, h = ci >> 6, d0 = ci & 63; const size_t img = ((size_t)((b * 8 + h) * 32 + tile)) * 8192;
                if (pn < 4) { base = SBK + img + (d0 >> 3) * 1024 + key * 16; sm = 256; } else { base = SBV + img + (d0 >> 5) * 4096 + key * 64 + (d0 & 31) * 2; sm = 1024; } }
            else { const int isv = cc >> 7, g = (cc >> 6) & 1, d0 = cc & 63, wimg = (pn - 9) * 2 + isv; const size_t img = ((size_t)(((wimg * 16 + b) * 2 + g) * 32 + tile)) * 8192;
                if (!isv) { base = NSAI + img + (d0 >> 3) * 1024 + key * 16; sm = 256; } else { base = NSAI + img + (d0 >> 5) * 4096 + key * 64 + (d0 & 31) * 2; sm = 1024; } }
            if (skip) continue;
#pragma unroll
            for (int ai = 0; ai < 2; ++ai)
#pragma unroll
                for (int m = 0; m < 4; ++m) { f32x4 v0 = acc[ai][bj][m][0] * sc, v1 = acc[ai][bj][m][1] * sc; unsigned char* dp = base + m * sm + ai * sa;
                    if (gate) {
#pragma unroll
                        for (int e = 0; e < 4; ++e) { v0[e] = sigmoid_f(v0[e]); v1[e] = sigmoid_f(v1[e]); }
                        *(f32x4*)dp = v0; *(f32x4*)(dp + 16) = v1; }
                    else *(u32x4*)dp = pack8(v0, v1); } }
    }
};
struct EpiSwiGLU {
    static constexpr bool PERM = true;
    bf16_t* O; int ldc; int NJ;
    __device__ __forceinline__ void operator()(AccRef acc, const pg8::Unit& u, int wr, int wc, int fr, int fq) const {
        const int row0 = u.pm * 256 + wr * 64 + fr; const int col = (u.pn % NJ) * 128 + wc * 32 + 8 * fq;
#pragma unroll
        for (int ai = 0; ai < 2; ++ai)
#pragma unroll
            for (int m = 0; m < 4; ++m) { f32x4 v0, v1;
#pragma unroll
                for (int e = 0; e < 4; ++e) { v0[e] = silu_f(acc[ai][0][m][0][e]) * acc[ai][1][m][0][e]; v1[e] = silu_f(acc[ai][0][m][1][e]) * acc[ai][1][m][1][e]; }
                *(u32x4*)(O + (size_t)(row0 + ai * 128 + m * 16) * ldc + col) = pack8(v0, v1); }
    }
};
struct EpiConvIn {
    static constexpr bool PERM = true;
    bf16_t* Z; bf16_t* GB;
    __device__ __forceinline__ void operator()(AccRef acc, const pg8::Unit& u, int wr, int wc, int fr, int fq) const {
        const int row0 = u.pm * 256 + wr * 64 + fr;
        if (u.pn < 8) { const int col = u.pn * 128 + wc * 32 + 8 * fq;
#pragma unroll
            for (int ai = 0; ai < 2; ++ai)
#pragma unroll
                for (int m = 0; m < 4; ++m) *(u32x4*)(Z + (size_t)(row0 + ai * 128 + m * 16) * DM + col) = pack8(acc[ai][0][m][0] * acc[ai][1][m][0], acc[ai][0][m][1] * acc[ai][1][m][1]);
        } else {
#pragma unroll
            for (int bj = 0; bj < 2; ++bj) { const int col = (u.pn - 8) * 256 + bj * 128 + wc * 32 + 8 * fq;
#pragma unroll
                for (int ai = 0; ai < 2; ++ai)
#pragma unroll
                    for (int m = 0; m < 4; ++m) *(u32x4*)(GB + (size_t)(row0 + ai * 128 + m * 16) * DM + col) = pack8(acc[ai][bj][m][0], acc[ai][bj][m][1]); }
        }
    }
};
struct EpiMoeDown {
    static constexpr bool PERM = false;
    float* out; const int* rowtok; const float* rowgate; const float* g2;
    __device__ __forceinline__ void operator()(AccRef acc, const pg8::Unit& u, int wr, int wc, int fr, int fq) const {
        const int row0 = u.pm * 256 + wr * 64 + fr; const int colt = (u.pn & 3) * 256 + wc * 32 + 4 * fq; const bool ATOMIC = u.nt != 0;
#pragma unroll
        for (int ai = 0; ai < 2; ++ai)
#pragma unroll
            for (int m = 0; m < 4; ++m) { const int row = row0 + ai * 128 + m * 16; const int tok = rowtok[row]; if (tok < 0) continue;
                const float gt = rowgate[row]; const float* gp = g2 + (size_t)(tok >> 11) * 6144; float* op = out + (size_t)tok * DM;
#pragma unroll
                for (int bj = 0; bj < 2; ++bj)
#pragma unroll
                    for (int n = 0; n < 2; ++n) { const int col = colt + bj * 128 + n * 16; const f32x4 gg = *(const f32x4*)(gp + col); const f32x4 v = (gg + 1.0f) * gt * acc[ai][bj][m][n];
                        if (ATOMIC) {
#pragma unroll
                            for (int e = 0; e < 4; ++e) (void)__hip_atomic_fetch_add(op + col + e, v[e], __ATOMIC_RELAXED, __HIP_MEMORY_SCOPE_AGENT); }
                        else { f32x4 o = *(f32x4*)(op + col); o += v; *(f32x4*)(op + col) = o; } } }
    }
};

struct Args {
    const float *x, *c, *ada_w, *ada_b, *ln_g, *ln_b, *mix_w_in, *cmp_pos, *cmp_w1, *cmp_w2, *mix_w_out, *ffn_w1, *ffn_w3, *ffn_w2,
                *conv_w_in, *conv_taps, *conv_w_out, *router_w, *router_b, *exp_w1, *exp_w3, *exp_w2;
    float* out; unsigned char* ws;
};

__device__ __forceinline__ void transpose_item(const float* W, int N, int k0, int n0, bf16_t* WT, int dK, int drow0, LAS float* scr, int lane) {
    const int n = n0 + (lane & 31); const bool ok = n < N;
    float tv[32];
#pragma unroll
    for (int i = 0; i < 32; ++i) { const int kk = 2 * i + (lane >> 5); tv[i] = ok ? W[(size_t)(k0 + kk) * N + n] : 0.f; }
#pragma unroll
    for (int i = 0; i < 32; ++i) { const int kk = 2 * i + (lane >> 5); scr[kk * 33 + (lane & 31)] = tv[i]; }
    asm volatile("s_waitcnt lgkmcnt(0)" ::: "memory");
    const int c = lane & 7;
#pragma unroll
    for (int j = 0; j < 4; ++j) { const int nn = (lane >> 3) + 8 * j; const LAS float* s = scr + (8 * c) * 33 + nn;
        u32x4 o; o.x = cvt_pk_bf16(s[0 * 33], s[1 * 33]); o.y = cvt_pk_bf16(s[2 * 33], s[3 * 33]); o.z = cvt_pk_bf16(s[4 * 33], s[5 * 33]); o.w = cvt_pk_bf16(s[6 * 33], s[7 * 33]);
        *(u32x4*)(WT + (size_t)(drow0 + nn) * dK + k0 + 8 * c) = o; }
    asm volatile("s_waitcnt lgkmcnt(0)" ::: "memory");
}
__device__ __forceinline__ int il1(int n) { return (n >> 7) * 256 + (n & 127); }
__device__ __forceinline__ void weight_item(const Args& a, int it, LAS float* scr, int lane) {
    unsigned char* ws = a.ws;
#define WITEM(cnt, SRC, KK, NN, NBLK, DST, MODE, ROFF) if (it < (cnt)) { const int bi_ = it >> 3, kb = bi_ % ((KK) / 64), nb = (bi_ / ((KK) / 64)) * 8 + (it & 7), n0 = nb * 32; int dr; \
        if ((MODE) == 0) dr = n0; else if ((MODE) == 1) dr = il1(n0); else if ((MODE) == 2) dr = il1(n0) + 128; \
        else dr = (n0 < 1024) ? 2048 + n0 : ((n0 < 2048) ? il1(n0 - 1024) : il1(n0 - 2048) + 128); \
        transpose_item((SRC), (NN), kb * 64, n0, (bf16_t*)(DST), (KK), dr + (ROFF), scr, lane); return; } it -= (cnt);
    WITEM(1536, a.mix_w_in, 1024, MIXN, 96, ws + W_MIX, 0, 0)
    WITEM(512, a.mix_w_out, 1024, 1024, 32, ws + W_OUT, 0, 0)
    WITEM(1408, a.ffn_w1, 1024, DFF, 88, ws + W_F13, 1, 0)
    WITEM(1408, a.ffn_w3, 1024, DFF, 88, ws + W_F13, 2, 0)
    WITEM(1408, a.ffn_w2, DFF, 1024, 32, ws + W_F2, 0, 0)
    WITEM(1536, a.conv_w_in, 1024, 3072, 96, ws + W_CIN, 3, 0)
    WITEM(512, a.conv_w_out, 1024, 1024, 32, ws + W_COUT, 0, 0)
    { const int e = it / 1408; if (e < 8) { int it2 = it % 1408; const int bi_ = it2 >> 3, kb = bi_ % 16, nb = (bi_ / 16) * 8 + (it2 & 7), n0 = nb * 32;
        transpose_item(a.exp_w1 + (size_t)e * 1024 * DFF, DFF, kb * 64, n0, (bf16_t*)(ws + W_E13), 1024, il1(n0) + e * 2 * DFF, scr, lane); return; } it -= 8 * 1408; }
    { const int e = it / 1408; if (e < 8) { int it2 = it % 1408; const int bi_ = it2 >> 3, kb = bi_ % 16, nb = (bi_ / 16) * 8 + (it2 & 7), n0 = nb * 32;
        transpose_item(a.exp_w3 + (size_t)e * 1024 * DFF, DFF, kb * 64, n0, (bf16_t*)(ws + W_E13), 1024, il1(n0) + 128 + e * 2 * DFF, scr, lane); return; } it -= 8 * 1408; }
    { const int e = it / 1408; if (e < 8) { int it2 = it % 1408; const int bi_ = it2 >> 3, kb = bi_ % 44, nb = (bi_ / 44) * 8 + (it2 & 7), n0 = nb * 32;
        transpose_item(a.exp_w2 + (size_t)e * DFF * 1024, 1024, kb * 64, n0, (bf16_t*)(ws + W_E2), DFF, n0 + e * 1024, scr, lane); return; } it -= 8 * 1408; }
    { const int w = it / 256; if (w < 2) { int it2 = it % 256; const int kb = it2 >> 3, nb = it2 & 7, n0 = nb * 32;
        transpose_item(a.cmp_w1 + (size_t)w * 2048 * 256, 256, kb * 64, n0, (bf16_t*)(ws + W_C1), 2048, n0 + w * 256, scr, lane); return; } it -= 512; }
    { const int w = it / 32; if (w < 2) { int it2 = it % 32; const int kb = it2 >> 3, nb = it2 & 7, n0 = nb * 32;
        transpose_item(a.cmp_w2 + (size_t)w * 256 * 64, 64, kb * 64, n0, (bf16_t*)(ws + W_C2), 256, n0 + w * 256, scr, lane); return; } }
#undef WITEM
}
constexpr int N_WITEMS = 1536 + 512 + 1408 * 3 + 1536 + 512 + 3 * 8 * 1408 + 512 + 64;

template <int NB>
__device__ __forceinline__ void gemv_block(LAS float* sv, LAS float* part, const float* W, int K, int N, int j0, const float* bias, float* out, int out_pitch, int tid) {
    const int wid = tid >> 6, lane = tid & 63, kc = K / 8, kb = wid * kc;
    float acc[NB];
#pragma unroll
    for (int b = 0; b < NB; ++b) acc[b] = 0.f;
    const float* wp = W + (size_t)kb * N + j0 + lane;
    for (int k0 = 0; k0 < kc; k0 += 16) {
        float wv[16];
#pragma unroll
        for (int j = 0; j < 16; ++j) wv[j] = wp[(size_t)(k0 + j) * N];
#pragma unroll
        for (int j = 0; j < 16; ++j)
#pragma unroll
            for (int b = 0; b < NB; ++b) acc[b] += sv[b * K + kb + k0 + j] * wv[j]; }
#pragma unroll
    for (int b = 0; b < NB; ++b) part[(wid * NB + b) * 64 + lane] = acc[b];
    __syncthreads();
    for (int idx = tid; idx < NB * 64; idx += 512) { const int b = idx >> 6, l = idx & 63; float s = 0.f;
#pragma unroll
        for (int w = 0; w < 8; ++w) s += part[(w * NB + b) * 64 + l];
        if (bias) s += bias[j0 + l];
        out[(size_t)b * out_pitch + j0 + l] = s; }
    __syncthreads();
}

__device__ __forceinline__ void phase_prologue(const Args& a, LAS unsigned char* lds, int tid) {
    const int wid = tid >> 6, lane = tid & 63, G = gridDim.x, bx = blockIdx.x;
    LAS float* sv = (LAS float*)lds;
    LAS float* part = (LAS float*)(lds + 65536);
    float* MOD = (float*)(a.ws + WS_MOD); float* CB = (float*)(a.ws + WS_CBIAS);
    bool have_silu = false;
    __syncthreads();
    for (int item = bx; item < 200; item += G) {
        if (item < 192) {
            if (!have_silu) { for (int i = tid; i < 16 * 1024; i += 512) sv[i] = silu_f(a.c[i]); __syncthreads(); have_silu = true; }
            const int li = item / 96, jg = item % 96;
            gemv_block<16>(sv, part, a.ada_w + (size_t)li * 1024 * 6144, 1024, 6144, jg * 64, a.ada_b + li * 6144, MOD + (size_t)li * 16 * 6144, 6144, tid);
        } else {
            const int q = item - 192, w = q >> 2, jg = q & 3;
            __syncthreads();
            for (int i = tid; i < 2048; i += 512) sv[i] = a.cmp_pos[w * 2048 + i];
            __syncthreads(); have_silu = false;
            gemv_block<1>(sv, part, a.cmp_w1 + (size_t)w * 2048 * 256, 2048, 256, jg * 64, nullptr, CB + w * 256, 256, tid);
        }
    }
    __syncthreads();
    if (bx == G - 1) for (int i = tid; i < 65536 / 16; i += 512) *(u32x4*)(a.ws + R3_KCPAD + (size_t)i * 16) = (u32x4){0u, 0u, 0u, 0u};
    LAS float* scr = (LAS float*)(lds + wid * 16384);
    { constexpr int NBI = N_WITEMS / 8; unsigned* head = (unsigned*)(a.ws + WS_CTL) + CW_WQ + 256; volatile LAS unsigned* wqw = (volatile LAS unsigned*)(lds + MISC_OFF + 128);
      for (;;) { __syncthreads(); if (tid == 0) *wqw = atomicAdd(head, 1u); __syncthreads(); const int bi = (int)*wqw; if (bi >= NBI) break;
          weight_item(a, bi * 8 + wid, scr, lane); } }
}

__device__ __forceinline__ void phase_modulate(const float* x, const float* sc, const float* sh, bf16_t* h, int tid) {
    const int wid = tid >> 6, lane = tid & 63;
    for (int row = blockIdx.x * 8 + wid; row < MTOK; row += gridDim.x * 8) { const int b = row >> 11;
#pragma unroll
        for (int j = 0; j < 4; ++j) { const int c = 4 * lane + 256 * j; const f32x4 v = *(const f32x4*)(x + (size_t)row * DM + c);
            const f32x4 s = *(const f32x4*)(sc + b * 6144 + c), t = *(const f32x4*)(sh + b * 6144 + c); const f32x4 o = v * (s + 1.0f) + t;
            u32x2 w; w.x = cvt_pk_bf16(o[0], o[1]); w.y = cvt_pk_bf16(o[2], o[3]); *(u32x2*)(h + (size_t)row * DM + c) = w; } }
}
template <bool HAS_Y, bool HAS_H, bool ROUTER>
__device__ __forceinline__ void phase_ln(const float* xin, float xscale, float oscale, const bf16_t* y, const float* gate, const float* lg, const float* lb, float* xout,
                                         bf16_t* hout, const float* sc, const float* sh, const float* rw, const float* rb, unsigned* ecnt, int* asg, float* agate, int tid) {
    const int wid = tid >> 6, lane = tid & 63;
    for (int row = blockIdx.x * 8 + wid; row < MTOK; row += gridDim.x * 8) { const int b = row >> 11;
        f32x4 v[4]; float s = 0.f;
#pragma unroll
        for (int j = 0; j < 4; ++j) { const int c = 4 * lane + 256 * j; v[j] = *(const f32x4*)(xin + (size_t)row * DM + c) * xscale;
            if (HAS_Y) { const u32x2 yw = *(const u32x2*)(y + (size_t)row * DM + c); const f32x4 gg = *(const f32x4*)(gate + b * 6144 + c);
                const f32x4 yv = (f32x4){bflo(yw.x), bfhi(yw.x), bflo(yw.y), bfhi(yw.y)}; v[j] += (gg + 1.0f) * yv; }
            s += (v[j][0] + v[j][1]) + (v[j][2] + v[j][3]); }
        const float mean = wave_sum(s) * (1.0f / DM); float s2 = 0.f;
#pragma unroll
        for (int j = 0; j < 4; ++j) { v[j] = v[j] - mean; s2 += (v[j][0] * v[j][0] + v[j][1] * v[j][1]) + (v[j][2] * v[j][2] + v[j][3] * v[j][3]); }
        const float rstd = 1.0f / sqrtf(wave_sum(s2) * (1.0f / DM) + LN_EPS);
        float lgt[8];
#pragma unroll
        for (int e = 0; e < 8; ++e) lgt[e] = 0.f;
#pragma unroll
        for (int j = 0; j < 4; ++j) { const int c = 4 * lane + 256 * j; const f32x4 g4 = *(const f32x4*)(lg + c), b4 = *(const f32x4*)(lb + c);
            const f32x4 xo = v[j] * rstd * g4 + b4; *(f32x4*)(xout + (size_t)row * DM + c) = xo * oscale;
            if (HAS_H) { const f32x4 s4 = *(const f32x4*)(sc + b * 6144 + c), t4 = *(const f32x4*)(sh + b * 6144 + c); const f32x4 hv = xo * (s4 + 1.0f) + t4;
                u32x2 w; w.x = cvt_pk_bf16(hv[0], hv[1]); w.y = cvt_pk_bf16(hv[2], hv[3]); *(u32x2*)(hout + (size_t)row * DM + c) = w;
                if (ROUTER) {
#pragma unroll
                    for (int q = 0; q < 4; ++q) { const f32x4 r0 = *(const f32x4*)(rw + (size_t)(c + q) * 8), r1 = *(const f32x4*)(rw + (size_t)(c + q) * 8 + 4);
#pragma unroll
                        for (int e = 0; e < 4; ++e) { lgt[e] += hv[q] * r0[e]; lgt[4 + e] += hv[q] * r1[e]; } } } } }
        if (ROUTER) {
#pragma unroll
            for (int e = 0; e < 8; ++e) lgt[e] = wave_sum(lgt[e]) + rb[e];
            int i1 = 0; float l1 = lgt[0];
#pragma unroll
            for (int e = 1; e < 8; ++e) if (lgt[e] > l1) { l1 = lgt[e]; i1 = e; }
            int i2 = -1; float l2 = -3.0e38f;
#pragma unroll
            for (int e = 0; e < 8; ++e) if (e != i1 && lgt[e] > l2) { l2 = lgt[e]; i2 = e; }
            const float ex = __expf(l2 - l1), den = 1.0f / (1.0f + ex);
            if (lane == 0) {
                const unsigned r1 = atomicAdd(ecnt + 64 * i1, 1u), r2 = atomicAdd(ecnt + 64 * (8 + i2), 1u);
                asg[row] = (i1 << 20) | (int)r1; asg[MTOK + row] = (i2 << 20) | (int)r2; agate[row] = den; agate[MTOK + row] = ex * den; }
        }
    }
}
__device__ __forceinline__ void phase_conv(const bf16_t* Z, const bf16_t* GB, const float* taps, bf16_t* A, int tid) {
    const int wid = tid >> 6, lane = tid & 63;
    for (int row = blockIdx.x * 8 + wid; row < MTOK; row += gridDim.x * 8) { const int t = row & 2047;
#pragma unroll
        for (int j = 0; j < 2; ++j) { const int c = 8 * lane + 512 * j;
            const u32x4 z2 = *(const u32x4*)(Z + (size_t)row * DM + c), gb = *(const u32x4*)(GB + (size_t)row * DM + c);
            u32x4 z1 = (u32x4){0u, 0u, 0u, 0u}, z0 = z1;
            if (t >= 1) z1 = *(const u32x4*)(Z + (size_t)(row - 1) * DM + c);
            if (t >= 2) z0 = *(const u32x4*)(Z + (size_t)(row - 2) * DM + c);
            u32x4 o;
#pragma unroll
            for (int q = 0; q < 4; ++q) { const int cc = c + 2 * q;
                const float a0 = bflo(gb[q]) * (taps[cc] * bflo(z0[q]) + taps[1024 + cc] * bflo(z1[q]) + taps[2048 + cc] * bflo(z2[q]));
                const float a1 = bfhi(gb[q]) * (taps[cc + 1] * bfhi(z0[q]) + taps[1024 + cc + 1] * bfhi(z1[q]) + taps[2048 + cc + 1] * bfhi(z2[q]));
                o[q] = cvt_pk_bf16(a0, a1); }
            *(u32x4*)(A + (size_t)row * DM + c) = o; } }
}
__device__ __forceinline__ void phase_moe_rows(unsigned char* ws, int tid) {
    unsigned* ctl = (unsigned*)(ws + WS_CTL); const int* asg = (const int*)(ws + WS_ASG); const float* agate = (const float*)(ws + WS_AGATE);
    int* rowtok = (int*)(ws + WS_ROWTOK); float* rowgate = (float*)(ws + WS_ROWGATE);
    int cnt[2][8], pst[2][8];
#pragma unroll
    for (int k = 0; k < 2; ++k) { int run = 0;
#pragma unroll
        for (int e = 0; e < 8; ++e) { cnt[k][e] = (int)xb_ld(ctl + CW_ECNT + 64 * (8 * k + e)); pst[k][e] = run; run += ((cnt[k][e] + 255) >> 8) << 8; } }
    const int gt = blockIdx.x * 512 + tid, GT = gridDim.x * 512;
    for (int idx = gt; idx < 2 * MTOK; idx += GT) { const int k = idx >= MTOK ? 1 : 0, tok = idx - k * MTOK; const int a = asg[idx], e = a >> 20, rk = a & 0xfffff;
        int ps = 0;
#pragma unroll
        for (int q = 0; q < 8; ++q) ps = (q == e) ? pst[k][q] : ps;
        const int row = ps + rk; rowtok[k * MOE_ROWS + row] = tok; rowgate[k * MOE_ROWS + row] = agate[idx]; }
    for (int idx = gt; idx < 2 * 8 * 256; idx += GT) { const int k = idx >> 11, e = (idx >> 8) & 7, q = idx & 255; int c = 0, ps = 0;
#pragma unroll
        for (int w = 0; w < 8; ++w) { c = (w == e) ? cnt[k][w] : c; ps = (w == e) ? pst[k][w] : ps; }
        const int row = ps + c + q, end = ps + (((c + 255) >> 8) << 8);
        if (row < end) { rowtok[k * MOE_ROWS + row] = -1; rowgate[k * MOE_ROWS + row] = 0.f; } }
    if (blockIdx.x == 0 && tid < 16) { const int k = tid >> 3, e = tid & 7; int te = 0;
#pragma unroll
        for (int w = 0; w < 8; ++w) if (w <= e) te += (cnt[k][w] + 255) >> 8;
        ctl[CW_TEND + 8 * k + e] = (unsigned)te; }
}

typedef short v4i16_t __attribute__((ext_vector_type(4)));
__device__ __forceinline__ f32x16 mfma32(bf16x8 a, bf16x8 b, f32x16 c) { return __builtin_amdgcn_mfma_f32_32x32x16_bf16(a, b, c, 0, 0, 0); }
__device__ __forceinline__ int crow(int r, int hi) { return (r & 3) + 8 * (r >> 2) + 4 * hi; }
__device__ __forceinline__ float xhalf_max(float v) { auto rr = __builtin_amdgcn_permlane32_swap(__float_as_uint(v), __float_as_uint(v), false, false); return fmaxf(__uint_as_float(rr[0]), __uint_as_float(rr[1])); }
__device__ __forceinline__ float xhalf_sum(float v) { auto rr = __builtin_amdgcn_permlane32_swap(__float_as_uint(v), __float_as_uint(v), false, false); return __uint_as_float(rr[0]) + __uint_as_float(rr[1]); }
struct KVStage { u32x4 k, v; };
__device__ __forceinline__ void kv_load(KVStage& s, const bf16_t* Kg, const bf16_t* Vg, int pitch, int key0, int wid, int lane) {
    s.k = *(const u32x4*)(Kg + (size_t)(key0 + lane) * pitch + wid * 8);
    s.v = *(const u32x4*)(Vg + (size_t)(key0 + 16 * (wid & 3) + (lane >> 2)) * pitch + (wid >> 2) * 32 + (lane & 3) * 8);
}
__device__ __forceinline__ void kv_store(const KVStage& s, LAS unsigned char* buf, int wid, int lane) {
    *(LAS u32x4*)(buf + wid * 1024 + lane * 16) = s.k;
    *(LAS u32x4*)(buf + 8192 + wid * 1024 + lane * 16) = s.v;
}
__device__ __forceinline__ void qk_tile(f32x16& s0, f32x16& s1, const LAS unsigned char* kb, const bf16x8 (&qr)[4], int r32, int hi) {
    s0 = (f32x16){}; s1 = (f32x16){};
#pragma unroll
    for (int d0 = 0; d0 < 4; ++d0) { const LAS unsigned char* p = kb + (2 * d0 + hi) * 1024 + r32 * 16;
        const bf16x8 k0 = *(const LAS bf16x8*)p, k1 = *(const LAS bf16x8*)(p + 512);
        s0 = mfma32(k0, qr[d0], s0); s1 = mfma32(k1, qr[d0], s1); }
}
__device__ __forceinline__ void pack_p(bf16x8 (&pb)[4], const f32x16& p0, const f32x16& p1) {
    u32x4 w;
    w.x = cvt_pk_bf16(p0[0], p0[1]); w.y = cvt_pk_bf16(p0[2], p0[3]); w.z = cvt_pk_bf16(p0[4], p0[5]); w.w = cvt_pk_bf16(p0[6], p0[7]); pb[0] = __builtin_bit_cast(bf16x8, w);
    w.x = cvt_pk_bf16(p0[8], p0[9]); w.y = cvt_pk_bf16(p0[10], p0[11]); w.z = cvt_pk_bf16(p0[12], p0[13]); w.w = cvt_pk_bf16(p0[14], p0[15]); pb[1] = __builtin_bit_cast(bf16x8, w);
    w.x = cvt_pk_bf16(p1[0], p1[1]); w.y = cvt_pk_bf16(p1[2], p1[3]); w.z = cvt_pk_bf16(p1[4], p1[5]); w.w = cvt_pk_bf16(p1[6], p1[7]); pb[2] = __builtin_bit_cast(bf16x8, w);
    w.x = cvt_pk_bf16(p1[8], p1[9]); w.y = cvt_pk_bf16(p1[10], p1[11]); w.z = cvt_pk_bf16(p1[12], p1[13]); w.w = cvt_pk_bf16(p1[14], p1[15]); pb[3] = __builtin_bit_cast(bf16x8, w);
}
__device__ __forceinline__ void pv_tile(f32x16& o0, f32x16& o1, const LAS unsigned char* vbuf, const bf16x8 (&pb)[4], int lane) {
    const int i = lane & 15, hi = lane >> 5;
    const LAS unsigned char* vb = vbuf + ((lane >> 4) & 1) * 32 + (i & 3) * 8 + (4 * hi + (i >> 2)) * 64;
#pragma unroll
    for (int ks = 0; ks < 4; ++ks) {
        const v4i16_t a0 = __builtin_amdgcn_ds_read_tr16_b64_v4i16((LAS v4i16_t*)(vb + ks * 1024));
        const v4i16_t a1 = __builtin_amdgcn_ds_read_tr16_b64_v4i16((LAS v4i16_t*)(vb + ks * 1024 + 512));
        const v4i16_t c0 = __builtin_amdgcn_ds_read_tr16_b64_v4i16((LAS v4i16_t*)(vb + 4096 + ks * 1024));
        const v4i16_t c1 = __builtin_amdgcn_ds_read_tr16_b64_v4i16((LAS v4i16_t*)(vb + 4096 + ks * 1024 + 512));
        const bf16x8 va = (bf16x8){a0[0], a0[1], a0[2], a0[3], a1[0], a1[1], a1[2], a1[3]};
        const bf16x8 vc = (bf16x8){c0[0], c0[1], c0[2], c0[3], c1[0], c1[1], c1[2], c1[3]};
        o0 = mfma32(va, pb[ks], o0); o1 = mfma32(vc, pb[ks], o1); }
}
__device__ __forceinline__ void store_ot(LAS unsigned char* stg, const f32x16& o0, const f32x16& o1, bf16_t* Og, int pitch, int lane) {
    const int r32 = lane & 31, hi = lane >> 5;
#pragma unroll
    for (int r = 0; r < 16; r += 2) { const int d = crow(r, hi);
        *(LAS unsigned*)(stg + r32 * 128 + d * 2) = cvt_pk_bf16(o0[r], o0[r + 1]);
        *(LAS unsigned*)(stg + r32 * 128 + 64 + d * 2) = cvt_pk_bf16(o1[r], o1[r + 1]); }
    asm volatile("s_waitcnt lgkmcnt(0)" ::: "memory");
#pragma unroll
    for (int i = 0; i < 4; ++i) { const int row = i * 8 + (lane >> 3), ch = lane & 7; const u32x4 v = *(const LAS u32x4*)(stg + row * 128 + ch * 16);
        *(u32x4*)(Og + (size_t)row * pitch + ch * 8) = v; }
    asm volatile("s_waitcnt lgkmcnt(0)" ::: "memory");
}

#define CK(a, r) (32 * (a) + ((r) & 3) + 8 * ((r) >> 2))
constexpr int ATT_RING = 0, ATT_SLOT = 16384, ATT_IMP = 65536, ATT_SEL = ATT_IMP + 4 * 64 * 33 * 4, ATT_DONE = ATT_SEL + 256, ATT_WQ = ATT_DONE + 64;
__device__ __forceinline__ int wq_next(unsigned* head, LAS unsigned char* lds, int tid) {
    __syncthreads();
    if (tid == 0) *(volatile LAS unsigned*)(lds + ATT_WQ) = atomicAdd(head, 1u);
    __syncthreads();
    return (int)*(volatile LAS unsigned*)(lds + ATT_WQ);
}
__device__ __forceinline__ void glds16(const void* gsrc, unsigned lds_dst) { unsigned keep;
    asm volatile("s_mov_b32 %0, m0\n\ts_mov_b32 m0, %2\n\ts_nop 0\n\tglobal_load_lds_dwordx4 %1, off\n\ts_mov_b32 m0, %0" : "=&s"(keep) : "v"(gsrc), "s"(lds_dst) : "memory"); }
__device__ __forceinline__ void kv_dma(LAS unsigned char* slot, const bf16_t* Kg, const bf16_t* Vg, int pitch, int key0, int wid, int lane) {
    const bf16_t* kp = Kg + (size_t)(key0 + lane) * pitch + wid * 8;
    const bf16_t* vp = Vg + (size_t)(key0 + 16 * (wid & 3) + (lane >> 2)) * pitch + (wid >> 2) * 32 + (lane & 3) * 8;
    const unsigned dst = (unsigned)__builtin_amdgcn_readfirstlane((int)(unsigned)(uintptr_t)(slot + wid * 1024));
    glds16(kp, dst); glds16(vp, dst + 8192u);
}
__device__ __forceinline__ void kv_dma_img(LAS unsigned char* slot, const unsigned char* Kimg, const unsigned char* Vimg, int wid, int lane) {
    const unsigned dst = (unsigned)__builtin_amdgcn_readfirstlane((int)(unsigned)(uintptr_t)(slot + wid * 1024));
    glds16(Kimg + wid * 1024 + lane * 16, dst); glds16(Vimg + wid * 1024 + lane * 16, dst + 8192u);
}
__device__ __forceinline__ void wait_bar(int ny) {
    if (ny >= 2) asm volatile("s_waitcnt vmcnt(4) lgkmcnt(0)\n\ts_barrier" ::: "memory");
    else if (ny == 1) asm volatile("s_waitcnt vmcnt(2) lgkmcnt(0)\n\ts_barrier" ::: "memory");
    else asm volatile("s_waitcnt vmcnt(0) lgkmcnt(0)\n\ts_barrier" ::: "memory");
}

constexpr float SB_DONE = 160.0f;
__device__ __forceinline__ void sb_unit(LAS unsigned char* lds, const bf16_t* Q, const unsigned char* SBK, const unsigned char* SBV, bf16_t* O, int b, int h, int qb, int wid, int lane) {
    const int r32 = lane & 31, hi = lane >> 5;
    const int qw = qb * 256 + wid * 32, tq = qw + r32;
    const bf16_t* Qp = Q + (size_t)(b * SEQ + tq) * DM + h * 64;
    bf16x8 qr[4];
#pragma unroll
    for (int d0 = 0; d0 < 4; ++d0) qr[d0] = *(const bf16x8*)(Qp + d0 * 16 + hi * 8);
    asm volatile("" : "+v"(qr[0]), "+v"(qr[1]), "+v"(qr[2]), "+v"(qr[3]));
    const unsigned char* Kimg = SBK + (size_t)((b * 8 + h) * 32) * 8192; const unsigned char* Vimg = SBV + (size_t)((b * 8 + h) * 32) * 8192;
    f32x16 o0 = (f32x16){}, o1 = (f32x16){}; float C = 0.f;
    const int nel = 4 * (qb + 1);
    LAS unsigned char* ring = lds + ATT_RING; LAS unsigned* DONE = (LAS unsigned*)(lds + ATT_DONE);
#pragma unroll
    for (int e = 0; e < 3; ++e) if (e < nel) kv_dma_img(ring + e * ATT_SLOT, Kimg + (size_t)(nel - 1 - e) * 8192, Vimg + (size_t)(nel - 1 - e) * 8192, wid, lane);
    bool wdone = false;
    for (int i = 0; i < nel; ++i) {
        const int jt = nel - 1 - i; const int li = (i + 2 < nel - 1) ? i + 2 : nel - 1;
        wait_bar(li - i);
        if (i > 0) { const unsigned f = DONE[(i & 1) * 8 + (lane & 7)]; if (__all(f != 0u)) break; }
        if (i + 3 < nel) kv_dma_img(ring + ((i + 3) & 3) * ATT_SLOT, Kimg + (size_t)(nel - 4 - i) * 8192, Vimg + (size_t)(nel - 4 - i) * 8192, wid, lane);
        const LAS unsigned char* buf = ring + (i & 3) * ATT_SLOT;
        if (!wdone && 64 * jt <= qw + 30) {
            f32x16 s0, s1; qk_tile(s0, s1, buf, qr, r32, hi);
            u32x4 wh[4], wl[4]; f32x2 tot2 = (f32x2){0.f, 0.f}; float tot;
            const int lim = tq - 64 * jt - 4 * hi;
#define SB_SPLUS(z) (fmaxf((z), 0.f) + fast_log2(1.0f + fast_exp2(-fabsf(z))))
#define SB_HI(x) __uint_as_float(__float_as_uint(x) & 0xffff0000u)
#define SB_PAIR(S, A, r, MASKED) do { float pa_ = SB_SPLUS(S[r]), pb2_ = SB_SPLUS(S[(r) + 1]); \
                if (MASKED) { const bool va_ = CK((A), (r)) < lim, vb_ = CK((A), (r) + 1) < lim; S[r] = va_ ? S[r] - pa_ : -1.0e30f; S[(r) + 1] = vb_ ? S[(r) + 1] - pb2_ : -1.0e30f; pa_ = va_ ? pa_ : 0.f; pb2_ = vb_ ? pb2_ : 0.f; } \
                else { S[r] -= pa_; S[(r) + 1] -= pb2_; } \
                tot2 += (f32x2){pa_, pb2_}; \
                wh[2 * (A) + ((r) >> 3)][((r) >> 1) & 3] = (__float_as_uint(pa_) >> 16) | (__float_as_uint(pb2_) & 0xffff0000u); \
                wl[2 * (A) + ((r) >> 3)][((r) >> 1) & 3] = cvt_pk_bf16(pa_ - SB_HI(pa_), pb2_ - SB_HI(pb2_)); } while (0)
            if (64 * jt + 63 < qw) {
#pragma unroll
                for (int r = 0; r < 16; r += 2) { SB_PAIR(s0, 0, r, false); SB_PAIR(s1, 1, r, false); }
            } else {
#pragma unroll
                for (int r = 0; r < 16; r += 2) { SB_PAIR(s0, 0, r, true); SB_PAIR(s1, 1, r, true); }
            }
#undef SB_PAIR
#undef SB_HI
#undef SB_SPLUS
            tot = tot2[0] + tot2[1];
            bf16x8 bh[4], bl[4];
#pragma unroll
            for (int q = 0; q < 4; ++q) { bh[q] = __builtin_bit_cast(bf16x8, wh[q]); bl[q] = __builtin_bit_cast(bf16x8, wl[q]); }
            bf16x8 tri[2], ones;
            { int rr = r32 - 4 * hi; asm volatile("" : "+v"(rr)); unsigned ou = 0x3F803F80u; asm volatile("" : "+v"(ou));
#pragma unroll
              for (int s2 = 0; s2 < 2; ++s2) { u32x4 w;
#pragma unroll
                  for (int q = 0; q < 4; ++q) { const int k0 = 16 * s2 + 8 * (q >> 1) + 2 * (q & 1);
                      w[q] = ((k0 > rr) ? 0x3F80u : 0u) | ((k0 + 1 > rr) ? 0x3F800000u : 0u); }
                  tri[s2] = __builtin_bit_cast(bf16x8, w); }
              ones = __builtin_bit_cast(bf16x8, (u32x4){ou, ou, ou, ou}); }
            f32x16 L0, L1;
#pragma unroll
            for (int r = 0; r < 16; ++r) { L0[r] = C; L1[r] = C; }
            L0 = mfma32(tri[0], bh[0], L0); L0 = mfma32(tri[0], bl[0], L0); L0 = mfma32(tri[1], bh[1], L0); L0 = mfma32(tri[1], bl[1], L0);
            L0 = mfma32(ones, bh[2], L0); L0 = mfma32(ones, bl[2], L0); L0 = mfma32(ones, bh[3], L0); L0 = mfma32(ones, bl[3], L0);
            L1 = mfma32(tri[0], bh[2], L1); L1 = mfma32(tri[0], bl[2], L1); L1 = mfma32(tri[1], bh[3], L1); L1 = mfma32(tri[1], bl[3], L1);
            C += xhalf_sum(tot);
#pragma unroll
            for (int r = 0; r < 16; ++r) { s0[r] = fast_exp2(s0[r] - L0[r]); s1[r] = fast_exp2(s1[r] - L1[r]); }
            bf16x8 pb[4]; pack_p(pb, s0, s1);
            pv_tile(o0, o1, buf + 8192, pb, lane);
            wdone = __all(C > SB_DONE);
        }
        if (lane == 0) DONE[((i + 1) & 1) * 8 + wid] = wdone ? 1u : 0u;
    }
    asm volatile("s_waitcnt vmcnt(0) lgkmcnt(0)\n\ts_barrier" ::: "memory");
    store_ot(ring + wid * 4096, o0, o1, O + (size_t)(b * SEQ + qw) * DM + h * 64, DM, lane);
}

__device__ __forceinline__ void qk_tile_c(f32x16& s0, f32x16& s1, const LAS unsigned char* kb, const bf16x8 (&qr)[4], const f32x16& cini, int r32, int hi) {
    s0 = cini; s1 = cini;
#pragma unroll
    for (int d0 = 0; d0 < 4; ++d0) { const LAS unsigned char* p = kb + (2 * d0 + hi) * 1024 + r32 * 16;
        const bf16x8 k0 = *(const LAS bf16x8*)p, k1 = *(const LAS bf16x8*)(p + 512);
        s0 = mfma32(k0, qr[d0], s0); s1 = mfma32(k1, qr[d0], s1); }
}
#define MAX3(a, b, c) __builtin_fmaxf(__builtin_fmaxf((a), (b)), (c))
constexpr float SM_THR = 8.0f;
#define SM_TILE(buf, c0, MASK, lim_, dbase_, first_) do { \
        f32x16 ci_; _Pragma("unroll") for (int r = 0; r < 16; ++r) ci_[r] = (c0); \
        f32x16 s0_, s1_; qk_tile_c(s0_, s1_, (buf), qr, ci_, r32, hi); \
        if ((MASK) == 1) { _Pragma("unroll") for (int r = 0; r < 16; ++r) { s0_[r] = (CK(0, r) <= (lim_)) ? s0_[r] : -1.0e30f; s1_[r] = (CK(1, r) <= (lim_)) ? s1_[r] : -1.0e30f; } } \
        if ((MASK) == 2) { _Pragma("unroll") for (int r = 0; r < 16; ++r) { s0_[r] = ((unsigned)((dbase_) - CK(0, r)) < 512u) ? s0_[r] : -1.0e30f; s1_[r] = ((unsigned)((dbase_) - CK(1, r)) < 512u) ? s1_[r] : -1.0e30f; } } \
        float ma_ = MAX3(s0_[0], s0_[1], s1_[0]), mb_ = MAX3(s0_[2], s0_[3], s1_[1]); ma_ = MAX3(ma_, s1_[2], s1_[3]); \
        _Pragma("unroll") for (int r = 4; r < 16; r += 4) { ma_ = MAX3(ma_, s0_[r], s0_[r + 1]); mb_ = MAX3(mb_, s0_[r + 2], s0_[r + 3]); ma_ = MAX3(ma_, s1_[r], s1_[r + 1]); mb_ = MAX3(mb_, s1_[r + 2], s1_[r + 3]); } \
        const float mx_ = xhalf_max(fmaxf(ma_, mb_)); \
        if (__any(mx_ > SM_THR) || (first_)) { const float dl_ = (first_) ? fmaxf(mx_, -100.f) : fmaxf(mx_, 0.f), al_ = fast_exp2(-dl_); m_run += dl_; l_run *= al_;   \
            _Pragma("unroll") for (int r = 0; r < 16; ++r) { s0_[r] -= dl_; s1_[r] -= dl_; oa0[r] *= al_; oa1[r] *= al_; } } \
        f32x2 ps_ = (f32x2){0.f, 0.f}; \
        _Pragma("unroll") for (int r = 0; r < 16; ++r) { s0_[r] = fast_exp2(s0_[r]); s1_[r] = fast_exp2(s1_[r]); ps_ += (f32x2){s0_[r], s1_[r]}; } \
        l_run += ps_[0] + ps_[1]; \
        bf16x8 pb_[4]; pack_p(pb_, s0_, s1_); pv_tile(oa0, oa1, (buf) + 8192, pb_, lane); } while (0)

__device__ __forceinline__ void nsa_unit(LAS unsigned char* lds, const bf16_t* Q, const unsigned char* NSAI, const bf16_t* KCV, const float* GATE, bf16_t* O, int b, int g, int tb, int wid, int lane) {
    const int r32 = lane & 31, hi = lane >> 5, rh = wid & 3, th = wid >> 2;
    const int tloc = 32 * th + r32, t = 64 * tb + tloc; const size_t row = (size_t)b * SEQ + t;
    bf16x8 qr[4];
    { const bf16_t* Qp = Q + row * DM + 512 + (g * 4 + rh) * 64;
#pragma unroll
      for (int d0 = 0; d0 < 4; ++d0) qr[d0] = *(const bf16x8*)(Qp + d0 * 16 + hi * 8); }
    const float* gp = GATE + row * 32 + g * 12 + rh * 3;
    float gt0 = gp[0], gt1 = gp[1], gt2 = gp[2];
    asm volatile("" : "+v"(qr[0]), "+v"(qr[1]), "+v"(qr[2]), "+v"(qr[3]), "+v"(gt0), "+v"(gt1), "+v"(gt2));
    f32x16 tot0, tot1;
    LAS unsigned char* ring = lds + ATT_RING;
    const unsigned char* ImS = NSAI + (size_t)(((0 * 16 + b) * 2 + g) * 32) * 8192; const unsigned char* ImW = NSAI + (size_t)(((2 * 16 + b) * 2 + g) * 32) * 8192;
    constexpr size_t VOFF = (size_t)16 * 2 * 32 * 8192;
    const int jw0 = tb >= 8 ? tb - 8 : 0, nwin = tb - jw0 + 1, nel = nwin + tb + 1;
#define EL_DMA(e, slotp) do { const unsigned char* ki_ = ((e) < nwin) ? ImW + (size_t)(jw0 + (e)) * 8192 : ImS + (size_t)((e) - nwin) * 8192; kv_dma_img((slotp), ki_, ki_ + VOFF, wid, lane); } while (0)
    {
        const bf16_t* Kc = KCV + (size_t)((b * 2 + g) * 128) * 64; const bf16_t* Vc = Kc + (size_t)4096 * 64;
        kv_dma(ring, Kc, Vc, 64, 0, wid, lane); kv_dma(ring + ATT_SLOT, Kc, Vc, 64, 64, wid, lane);
        EL_DMA(0, ring + 2 * ATT_SLOT); EL_DMA(1, ring + 3 * ATT_SLOT);
        wait_bar(2);
    }
    {
        f32x16 p[4];
        qk_tile(p[0], p[1], ring, qr, r32, hi); qk_tile(p[2], p[3], ring + ATT_SLOT, qr, r32, hi);
        float mx = -1.0e30f; const int tcmp = t - 31 - 64 * hi;
#pragma unroll
        for (int a = 0; a < 4; ++a)
#pragma unroll
            for (int r = 0; r < 16; ++r) { p[a][r] = (16 * CK(a, r) <= tcmp) ? p[a][r] : -1.0e30f; mx = fmaxf(mx, p[a][r]); }
        mx = fmaxf(xhalf_max(mx), -1.0e29f);
        float ls = 0.f;
#pragma unroll
        for (int a = 0; a < 4; ++a)
#pragma unroll
            for (int r = 0; r < 16; ++r) { p[a][r] = fast_exp2(p[a][r] - mx); ls += p[a][r]; }
        ls = xhalf_sum(ls); const float inv = ls > 0.f ? 1.0f / ls : 0.f;
#pragma unroll
        for (int a = 0; a < 4; ++a)
#pragma unroll
            for (int r = 0; r < 16; ++r) p[a][r] *= inv;
        LAS float* impw = (LAS float*)(lds + ATT_IMP) + (rh * 64 + tloc) * 33;
        float carry = 0.f;
#pragma unroll
        for (int a = 0; a < 4; ++a) {
            const float e0 = __shfl_xor(p[a][3], 32), e1 = __shfl_xor(p[a][7], 32), e2 = __shfl_xor(p[a][11], 32), e3 = __shfl_xor(p[a][15], 32);
            const float o0 = (p[a][0] + p[a][1]) + (p[a][2] + p[a][3]), o1 = (p[a][4] + p[a][5]) + (p[a][6] + p[a][7]);
            const float o2 = (p[a][8] + p[a][9]) + (p[a][10] + p[a][11]), o3 = (p[a][12] + p[a][13]) + (p[a][14] + p[a][15]);
            impw[8 * a + 0 + hi] = o0 + (hi ? e0 : carry);
            impw[8 * a + 2 + hi] = o1 + (hi ? e1 : e0);
            impw[8 * a + 4 + hi] = o2 + (hi ? e2 : e1);
            impw[8 * a + 6 + hi] = o3 + (hi ? e3 : e2);
            carry = e3; }
#pragma unroll
        for (int a = 0; a < 4; ++a)
#pragma unroll
            for (int r = 0; r < 16; ++r) p[a][r] *= gt0;
        tot0 = (f32x16){}; tot1 = (f32x16){};
        { bf16x8 pb[4]; pack_p(pb, p[0], p[1]); pv_tile(tot0, tot1, ring + 8192, pb, lane); }
        { bf16x8 pb[4]; pack_p(pb, p[2], p[3]); pv_tile(tot0, tot1, ring + ATT_SLOT + 8192, pb, lane); }
    }
    f32x16 oa0 = (f32x16){}, oa1 = (f32x16){}; float m_run = 0.f, l_run = 0.f; unsigned selmask = 0u;
    for (int i = 0; i < nel; ++i) {
        const int li = (i == 0) ? 1 : ((i + 2 < nel - 1) ? i + 2 : nel - 1);
        wait_bar(li - i);
        if (i == 0) { if (2 < nel) EL_DMA(2, ring); if (3 < nel) EL_DMA(3, ring + ATT_SLOT); }
        else if (i + 3 < nel) EL_DMA(i + 3, ring + ((i + 5) & 3) * ATT_SLOT);
        if (i == 0) {
            const LAS float* imp = (const LAS float*)(lds + ATT_IMP);
            LAS unsigned* SEL = (LAS unsigned*)(lds + ATT_SEL);
#pragma unroll 1
            for (int it = 0; it < 4; ++it) { const int tl = 8 * wid + 2 * it + hi, sb = r32;
                const float v = ((imp[(0 * 64 + tl) * 33 + sb] + imp[(1 * 64 + tl) * 33 + sb]) + imp[(2 * 64 + tl) * 33 + sb]) + imp[(3 * 64 + tl) * 33 + sb];
                const bool valid = sb <= tb, forced = (sb == 0) || (sb == tb) || (sb == tb - 1);
                const float val = valid ? (forced ? 1.0e30f : v) : -1.0e30f;
                int rank = 0;
#pragma unroll 8
                for (int s2 = 0; s2 < 32; ++s2) { const float o = __shfl(val, (lane & 32) | s2); rank += ((o > val) || (o == val && s2 < sb)) ? 1 : 0; }
                const unsigned long long bal = __ballot(rank < 16);
                if (lane == 0) { SEL[8 * wid + 2 * it] = (unsigned)bal; SEL[8 * wid + 2 * it + 1] = (unsigned)(bal >> 32); } }
        }
        if (i == nwin) {
            const float lt = xhalf_sum(l_run); const float sc = (lt > 0.f ? 1.0f / lt : 0.f) * gt2;
#pragma unroll
            for (int r = 0; r < 16; ++r) { tot0[r] += sc * oa0[r]; tot1[r] += sc * oa1[r]; oa0[r] = 0.f; oa1[r] = 0.f; }
            m_run = 0.f; l_run = 0.f;
            selmask = *(const LAS unsigned*)(lds + ATT_SEL + tloc * 4);
        }
        const LAS unsigned char* buf = ring + ((i + 2) & 3) * ATT_SLOT;
        if (i < nwin) { const int j = jw0 + i; const int dbase = 64 * (tb - j) + tloc - 4 * hi;
            if (j == tb || (tb >= 8 && j == jw0)) SM_TILE(buf, -m_run, 2, 0, dbase, i == 0);
            else SM_TILE(buf, -m_run, 0, 0, 0, i == 0);
        } else { const int j = i - nwin; const bool rs = (selmask >> j) & 1u;
            if (j == tb) { const int lim = tloc - 4 * hi; SM_TILE(buf, -m_run, 1, lim, 0, j == 0); }
            else { const float c0 = rs ? -m_run : -1.0e30f; SM_TILE(buf, c0, 0, 0, 0, j == 0); }
        }
    }
    { const float lt = xhalf_sum(l_run); const float sc = (lt > 0.f ? 1.0f / lt : 0.f) * gt1;
#pragma unroll
      for (int r = 0; r < 16; ++r) { tot0[r] += sc * oa0[r]; tot1[r] += sc * oa1[r]; } }
    asm volatile("s_waitcnt vmcnt(0) lgkmcnt(0)\n\ts_barrier" ::: "memory");
    store_ot(ring + wid * 4096, tot0, tot1, O + ((size_t)b * SEQ + 64 * tb + 32 * th) * DM + 512 + (g * 4 + rh) * 64, DM, lane);
#undef EL_DMA
}
#undef SM_TILE
#undef MAX3

#ifndef PHSEL
#define PHSEL 0xffffffffu
#endif
#ifndef ATTREP
#define ATTREP 1
#endif
#ifndef REPMASK
#define REPMASK 0u
#endif
#define PH(n) _Pragma("unroll") for (int rep_ = 0; rep_ < (int)(((PHSEL >> (n)) & 1u) + ((REPMASK >> (n)) & 1u)); ++rep_)
typedef const __attribute__((address_space(4))) Args* KArgP;
__device__ __forceinline__ KArgP opq_kernarg() { unsigned long long p = (unsigned long long)__builtin_amdgcn_kernarg_segment_ptr(); asm volatile("" : "+s"(p)); return (KArgP)p; }
__device__ __forceinline__ Args load_args() { Args r; const __attribute__((address_space(4))) unsigned long long* q = (const __attribute__((address_space(4))) unsigned long long*)opq_kernarg();
#pragma unroll
    for (int i = 0; i < (int)(sizeof(Args) / 8); ++i) ((unsigned long long*)&r)[i] = q[i];
    return r; }
#define KARGS const Args a = load_args(); unsigned char* const ws = a.ws; unsigned* const ctl = (unsigned*)(ws + WS_CTL); \
    const float* const MOD0 = (const float*)(ws + WS_MOD); const float* const MOD1 = MOD0 + 16 * 6144; \
    bf16_t* const R1 = (bf16_t*)(ws + WS_R1); bf16_t* const R2 = (bf16_t*)(ws + WS_R2); bf16_t* const R3 = (bf16_t*)(ws + WS_R3); \
    bf16_t* const KC = (bf16_t*)(ws + R3_KC); float* const GATE = (float*)(ws + R3_GATE); bf16_t* const HID = (bf16_t*)(ws + R3_HID); bf16_t* const KCV = (bf16_t*)(ws + R3_KCV); \
    (void)ctl; (void)MOD0; (void)MOD1; (void)R1; (void)R2; (void)R3; (void)KC; (void)GATE; (void)HID; (void)KCV;
__global__ void __launch_bounds__(512, 2) hybrid_fwd(Args a_unused) {
    extern __shared__ __attribute__((aligned(16))) unsigned char lds_raw[];
    LAS unsigned char* lds = (LAS unsigned char*)lds_raw;
    const int tid0 = threadIdx.x;
    const int G = gridDim.x, bx = blockIdx.x;
    volatile LAS unsigned* MISC = (volatile LAS unsigned*)(lds + MISC_OFF);
    if (tid0 < 32) MISC[tid0] = 0u;
    __syncthreads();
    XcdBarrier bar;
    { KARGS bar = xcd_barrier_post(ctl + CW_BAR, MISC + 8); }
#define GRID_BAR() xcd_barrier(bar)

    PH(0) { KARGS phase_prologue(a, lds, opaque_tid()); }
    GRID_BAR();
    PH(1) { KARGS phase_modulate(a.x, MOD0 + 1024, MOD0, R1, opaque_tid()); }
    GRID_BAR();
    PH(2) { KARGS pg8::Gemm g{R1, (const bf16_t*)(ws + W_MIX), DM, DM, nullptr}; GridOrder S; S.init(MTOK / 256, MIXNP / 256, G, bx);
      EpiMix E{(bf16_t*)(ws + R2_Q), ws + R2_SBK, ws + R2_SBV, ws + R2_NSA, KC, GATE};
      pg8::gemm_phase<EpiMix, GridOrder, true, false>(lds, g, S, E); }
    GRID_BAR();
    PH(3) if (bx < 32) { KARGS
        { pg8::Gemm g{KC, (const bf16_t*)(ws + W_C1), 1024, 2048, nullptr}; CmpOrder S{G, bx};
          EpiPlain<1> E{HID, 256, (const float*)(ws + WS_CBIAS), 256, 1};
          pg8::gemm_phase<EpiPlain<1>, CmpOrder, false, false>(lds, g, S, E); }
        asm volatile("s_waitcnt vmcnt(0)" ::: "memory"); __syncthreads();
        __builtin_amdgcn_fence(__ATOMIC_ACQUIRE, "agent"); asm volatile("s_waitcnt vmcnt(0)" ::: "memory"); __syncthreads();
        { pg8::Gemm g{HID, (const bf16_t*)(ws + W_C2), 256, 256, nullptr}; CmpOrder S{G, bx};
          EpiPlain<0> E{KCV, 64, nullptr, 64, 1};
          pg8::gemm_phase<EpiPlain<0>, CmpOrder, false, false>(lds, g, S, E); }
    }
    PH(4) { KARGS const int tid = opaque_tid(), lane = tid & 63, wid = __builtin_amdgcn_readfirstlane(tid >> 6);
      for (;;) { const int u = wq_next(ctl + CW_WQ, lds, opaque_tid()); if (u >= 1024) break;
        for (int q_ = 0; q_ < ATTREP; ++q_) { sb_unit(lds, (const bf16_t*)(ws + R2_Q), ws + R2_SBK, ws + R2_SBV, R1, (u & 127) >> 3, u & 7, 7 - (u >> 7), wid, lane); __syncthreads(); } } }
    GRID_BAR();
    PH(5) { KARGS const int tid = opaque_tid(), lane = tid & 63, wid = __builtin_amdgcn_readfirstlane(tid >> 6);
      for (;;) { const int u = wq_next(ctl + CW_WQ + 64, lds, opaque_tid()); if (u >= 1024) break;
        for (int q_ = 0; q_ < ATTREP; ++q_) { nsa_unit(lds, (const bf16_t*)(ws + R2_Q), ws + R2_NSA, KCV, GATE, R1, (u & 31) >> 1, u & 1, 31 - (u >> 5), wid, lane); __syncthreads(); } } }
    GRID_BAR();
    PH(6) { KARGS pg8::Gemm g{R1, (const bf16_t*)(ws + W_OUT), DM, DM, nullptr}; GridOrder S; S.init(MTOK / 256, 4, G, bx);
      EpiPlain<0> E{R3, DM, nullptr, DM, 4};
      pg8::gemm_phase<EpiPlain<0>, GridOrder, true, false>(lds, g, S, E); }
    GRID_BAR();
    PH(7) { KARGS phase_ln<true, true, false>(a.x, DN_ALPHA, 1.0f, R3, MOD0 + 2048, a.ln_g, a.ln_b, a.out, R1, MOD0 + 4096, MOD0 + 3072, nullptr, nullptr, nullptr, nullptr, nullptr, opaque_tid()); }
    GRID_BAR();
    PH(8) { KARGS pg8::Gemm g{R1, (const bf16_t*)(ws + W_F13), DM, DM, nullptr}; GridOrder S; S.init(MTOK / 256, 22, G, bx);
      EpiSwiGLU E{R2, DFF, 22};
      pg8::gemm_phase<EpiSwiGLU, GridOrder, true, false>(lds, g, S, E); }
    GRID_BAR();
    PH(9) { KARGS pg8::Gemm g{R2, (const bf16_t*)(ws + W_F2), DFF, DFF, nullptr}; GridOrder S; S.init(MTOK / 256, 4, G, bx);
      EpiPlain<0> E{R3, DM, nullptr, DM, 4};
      pg8::gemm_phase<EpiPlain<0>, GridOrder, true, false>(lds, g, S, E); }
    GRID_BAR();
    PH(10) { KARGS phase_ln<true, true, false>(a.out, DN_ALPHA, 1.0f, R3, MOD0 + 5120, a.ln_g + 1024, a.ln_b + 1024, a.out, R1, MOD1 + 1024, MOD1, nullptr, nullptr, nullptr, nullptr, nullptr, opaque_tid()); }
    GRID_BAR();
    PH(11) { KARGS pg8::Gemm g{R1, (const bf16_t*)(ws + W_CIN), DM, DM, nullptr}; GridOrder S; S.init(MTOK / 256, 12, G, bx);
      EpiConvIn E{R2, R2 + (size_t)MTOK * DM};
      pg8::gemm_phase<EpiConvIn, GridOrder, true, false>(lds, g, S, E); }
    GRID_BAR();
    PH(12) { KARGS phase_conv(R2, R2 + (size_t)MTOK * DM, a.conv_taps, R3, opaque_tid()); }
    GRID_BAR();
    PH(13) { KARGS pg8::Gemm g{R3, (const bf16_t*)(ws + W_COUT), DM, DM, nullptr}; GridOrder S; S.init(MTOK / 256, 4, G, bx);
      EpiPlain<0> E{R1, DM, nullptr, DM, 4};
      pg8::gemm_phase<EpiPlain<0>, GridOrder, true, false>(lds, g, S, E); }
    GRID_BAR();
    PH(14) { KARGS phase_ln<true, true, true>(a.out, DN_ALPHA, DN_ALPHA, R1, MOD1 + 2048, a.ln_g + 2048, a.ln_b + 2048, a.out, R3, MOD1 + 4096, MOD1 + 3072, a.router_w, a.router_b,
                               ctl + CW_ECNT, (int*)(ws + WS_ASG), (float*)(ws + WS_AGATE), opaque_tid()); }
    GRID_BAR();
    PH(15) { KARGS phase_moe_rows(ws, opaque_tid()); }
    GRID_BAR();
#pragma unroll 1
    for (int k = 0; k < 2; ++k) {
        MoeOrder S; S.G = G; S.c = bx; S.tend = (const LAS unsigned*)(lds + MISC_OFF + 64);
        __syncthreads();
        { KARGS if (tid0 < 8) ((LAS unsigned*)(lds + MISC_OFF + 64))[tid0] = xb_ld(ctl + CW_TEND + 8 * k + tid0); }
        __syncthreads();
        const int nt_all = __builtin_amdgcn_readfirstlane((int)S.tend[7]);
        PH(16) { KARGS const int* rowtok = (const int*)(ws + WS_ROWTOK) + k * MOE_ROWS;
          S.NJ = 22; S.ntiles = nt_all; S.nsplit = 0; pg8::Gemm g{R3, (const bf16_t*)(ws + W_E13), DM, DM, rowtok};
          EpiSwiGLU E{(bf16_t*)(ws + WS_R1), DFF, 22};
          pg8::gemm_phase<EpiSwiGLU, MoeOrder, true, true>(lds, g, S, E); }
        GRID_BAR();
        PH(17) { KARGS const int* rowtok = (const int*)(ws + WS_ROWTOK) + k * MOE_ROWS; const float* rowgate = (const float*)(ws + WS_ROWGATE) + k * MOE_ROWS;
          const int nmain = nt_all < 128 ? nt_all : 128;
          S.NJ = 4; S.ntiles = nmain; S.nsplit = nt_all - nmain; pg8::Gemm g{(const bf16_t*)(ws + WS_R1), (const bf16_t*)(ws + W_E2), DFF, DFF, nullptr};
          EpiMoeDown E{a.out, rowtok, rowgate, MOD1 + 5120}; pg8::gemm_phase<EpiMoeDown, MoeOrder, true, false>(lds, g, S, E); }
        GRID_BAR();
    }
    PH(18) { KARGS phase_ln<false, false, false>(a.out, 1.0f, 1.0f, nullptr, nullptr, a.ln_g + 3072, a.ln_b + 3072, a.out, nullptr, nullptr, nullptr, nullptr, nullptr, nullptr, nullptr, nullptr, opaque_tid()); }
#undef GRID_BAR
}

extern "C" void kernel_launch(void* const* d_in, const int* in_sizes, int n_in, void* d_out, int out_size, void* d_ws, size_t ws_size, hipStream_t stream) {
    static int grid = 0;
    if (grid == 0) {
        if (n_in != 22 || in_sizes[0] != MTOK * DM || out_size != MTOK * DM || ws_size < WS_END) {
            fprintf(stderr, "kernel_launch: unexpected problem (n_in %d, in0 %d, out %d, ws %zu); nothing launched\n", n_in, n_in > 0 ? in_sizes[0] : -1, out_size, ws_size); grid = -1; return; }
        int dev = 0, cus = 0, per_cu = 0;
        if (hipGetDevice(&dev) != hipSuccess || hipDeviceGetAttribute(&cus, hipDeviceAttributeMultiprocessorCount, dev) != hipSuccess) { grid = -1; return; }
        if (hipFuncSetAttribute((const void*)hybrid_fwd, hipFuncAttributeMaxDynamicSharedMemorySize, LDS_BYTES) != hipSuccess) { fprintf(stderr, "kernel_launch: hipFuncSetAttribute failed\n"); grid = -1; return; }
        if (hipOccupancyMaxActiveBlocksPerMultiprocessor(&per_cu, (const void*)hybrid_fwd, 512, LDS_BYTES) != hipSuccess || per_cu < 1)
            fprintf(stderr, "kernel_launch: note: occupancy query reports %d workgroups per CU\n", per_cu);
        (void)hipGetLastError();
        grid = cus;
    }
    if (grid < 0) return;
    if (hipMemsetAsync((char*)d_ws + WS_CTL, 0, CTL_BYTES, stream) != hipSuccess) { fprintf(stderr, "kernel_launch: hipMemsetAsync failed\n"); return; }
    Args a{};
    a.x = (const float*)d_in[0]; a.c = (const float*)d_in[1]; a.ada_w = (const float*)d_in[2]; a.ada_b = (const float*)d_in[3]; a.ln_g = (const float*)d_in[4]; a.ln_b = (const float*)d_in[5];
    a.mix_w_in = (const float*)d_in[6]; a.cmp_pos = (const float*)d_in[7]; a.cmp_w1 = (const float*)d_in[8]; a.cmp_w2 = (const float*)d_in[9]; a.mix_w_out = (const float*)d_in[10];
    a.ffn_w1 = (const float*)d_in[11]; a.ffn_w3 = (const float*)d_in[12]; a.ffn_w2 = (const float*)d_in[13]; a.conv_w_in = (const float*)d_in[14]; a.conv_taps = (const float*)d_in[15];
    a.conv_w_out = (const float*)d_in[16]; a.router_w = (const float*)d_in[17]; a.router_b = (const float*)d_in[18]; a.exp_w1 = (const float*)d_in[19]; a.exp_w3 = (const float*)d_in[20];
    a.exp_w2 = (const float*)d_in[21];
    a.out = (float*)d_out; a.ws = (unsigned char*)d_ws;
    hipLaunchKernelGGL(hybrid_fwd, dim3(grid), dim3(512), LDS_BYTES, stream, a);
    const hipError_t le = hipPeekAtLastError();
    if (le != hipSuccess) fprintf(stderr, "kernel_launch: launch failed: %s\n", hipGetErrorName(le));
}
```

```cpp
#include <hip/hip_runtime.h>
#include <cstdio>
#include <cstdint>

#define LAS __attribute__((address_space(3)))
#define GAS __attribute__((address_space(1)))
typedef unsigned short bf16_t;
typedef short bf16x8 __attribute__((ext_vector_type(8)));
typedef short s16x4 __attribute__((ext_vector_type(4)));
typedef float f32x4 __attribute__((ext_vector_type(4)));
typedef float f32x2 __attribute__((ext_vector_type(2)));
typedef float f32x16 __attribute__((ext_vector_type(16)));
typedef unsigned u32x4 __attribute__((ext_vector_type(4)));
typedef unsigned u32x2 __attribute__((ext_vector_type(2)));

constexpr int BATCH = 16, SEQ = 2048, DM = 1024, MTOK = BATCH * SEQ;
constexpr int NPROJ = 2816;
constexpr int MIXN = 2840, MIXNP = 3072;
constexpr int DFF = 2816, NEXP = 8;
constexpr int MOE_ROWS = 34816;
constexpr float LN_EPS = 1e-5f;
constexpr float DN_ALPHA = 1.4142135623730951f;
constexpr float LOG2E = 1.4426950408889634f;
constexpr float QSCALE = 0.125f * LOG2E;

constexpr size_t MiB = 1u << 20;
constexpr size_t WS_CTL = 0, CTL_BYTES = 1 * MiB;
constexpr size_t WS_SMALL = 1 * MiB;
constexpr size_t WS_MOD = WS_SMALL;
constexpr size_t WS_CBIAS = WS_MOD + 786432;
constexpr size_t WS_ASG = WS_CBIAS + 4096;
constexpr size_t WS_AGATE = WS_ASG + 2 * MTOK * 4;
constexpr size_t WS_ROWTOK = WS_AGATE + 2 * MTOK * 4;
constexpr size_t WS_ROWGATE = WS_ROWTOK + 2 * MOE_ROWS * 4;
constexpr size_t WS_SMALL_END = WS_ROWGATE + 2 * MOE_ROWS * 4;
static_assert(WS_SMALL_END <= 8 * MiB, "small tables");
constexpr size_t WS_W = 8 * MiB;
constexpr size_t W_MIX = WS_W;
constexpr size_t W_OUT = W_MIX + (size_t)MIXNP * DM * 2;
constexpr size_t W_F13 = W_OUT + (size_t)DM * DM * 2;
constexpr size_t W_F2 = W_F13 + (size_t)2 * DFF * DM * 2;
constexpr size_t W_CIN = W_F2 + (size_t)DM * DFF * 2;
constexpr size_t W_COUT = W_CIN + (size_t)3 * DM * DM * 2;
constexpr size_t W_E13 = W_COUT + (size_t)DM * DM * 2;
constexpr size_t W_E2 = W_E13 + (size_t)NEXP * 2 * DFF * DM * 2;
constexpr size_t W_C1 = W_E2 + (size_t)NEXP * DM * DFF * 2;
constexpr size_t W_C2 = W_C1 + (size_t)2 * 256 * 2048 * 2;
constexpr size_t WS_W_END = W_C2 + (size_t)2 * 256 * 256 * 2;
constexpr size_t WS_R1 = 176 * MiB;
constexpr size_t WS_R2 = 240 * MiB;
constexpr size_t WS_R3 = 416 * MiB;
constexpr size_t WS_END = 480 * MiB;
static_assert(WS_W_END <= WS_R1, "weights fit");
static_assert((size_t)MOE_ROWS * DFF * 2 <= WS_R3 - WS_R1, "MoE activation chunk fits R1+R2");
constexpr size_t R2_Q = WS_R2;
constexpr size_t R2_SBK = WS_R2 + 64 * MiB;
constexpr size_t R2_SBV = WS_R2 + 96 * MiB;
constexpr size_t R2_NSA = WS_R2 + 128 * MiB;
constexpr size_t R3_KC = WS_R3;
constexpr size_t R3_KCPAD = R3_KC + 16 * MiB;
constexpr size_t R3_GATE = R3_KC + 17 * MiB;
constexpr size_t R3_HID = R3_KC + 21 * MiB;
constexpr size_t R3_KCV = R3_KC + 25 * MiB;

constexpr int CW_BAR = 4096;
constexpr int CW_WQ = 8192;
constexpr int CW_ECNT = 9216;
constexpr int CW_TEND = 12288;

constexpr int LDS_BYTES = 147456;
constexpr int MISC_OFF = 131072 + 320;

__device__ __forceinline__ unsigned cvt_pk_bf16(float lo, float hi) { unsigned r; asm volatile("v_cvt_pk_bf16_f32 %0, %1, %2" : "=v"(r) : "v"(lo), "v"(hi)); return r; }
__device__ __forceinline__ float bf2f(bf16_t v) { return __uint_as_float((unsigned)v << 16); }
__device__ __forceinline__ float bflo(unsigned w) { return __uint_as_float(w << 16); }
__device__ __forceinline__ float bfhi(unsigned w) { return __uint_as_float(w & 0xffff0000u); }
__device__ __forceinline__ float fast_exp2(float x) { return __builtin_amdgcn_exp2f(x); }
__device__ __forceinline__ float fast_log2(float x) { return __builtin_amdgcn_logf(x); }
__device__ __forceinline__ float fast_rcp(float x) { return __builtin_amdgcn_rcpf(x); }
__device__ __forceinline__ float silu_f(float a) { return a * fast_rcp(1.0f + fast_exp2(-a * LOG2E)); }
__device__ __forceinline__ float sigmoid_f(float a) { return fast_rcp(1.0f + fast_exp2(-a * LOG2E)); }
__device__ __forceinline__ float wave_sum(float v) {
#pragma unroll
    for (int o = 1; o < 64; o <<= 1) v += __shfl_xor(v, o);
    return v;
}

__device__ __forceinline__ int opaque_tid() { int t = threadIdx.x; asm volatile("" : "+v"(t)); return t; }

namespace pg8 {
constexpr int BM = 256, BK = 64, HALF = 128, HTB = HALF * BK * 2, STAGE_BYTES = 8 * HTB;
__host__ __device__ __forceinline__ int lds_byte(int r, int c) { const int st = (r >> 4) * 2 + (c >> 5), rr = r & 15, cc = c & 31, ob = rr * 64 + cc * 2; return st * 1024 + (ob ^ (((ob >> 9) & 1) << 5)); }
__host__ __device__ __forceinline__ void stage_rc(int b, int& R, int& C) { const int st = b / 1024, sb = b % 1024, swz = sb ^ (((sb >> 9) & 1) << 5); R = (st >> 1) * 16 + swz / 64; C = (st & 1) * 32 + (swz % 64) / 2; }
__host__ __device__ __forceinline__ int perm32(int rho) { const int n = rho >> 4, i = rho & 15; return 8 * (i >> 2) + 4 * n + (i & 3); }

struct Unit { int pm, pn, koff, nt; };
struct Gemm { const bf16_t* A; const bf16_t* Bt; int lda; int K; const int* rowidx; int ldb; };

template <class Epi, class Sched, bool ALIGN_EPI, bool GATHER>
__device__ __forceinline__ void gemm_phase(LAS unsigned char* lds, const Gemm g, const Sched& S, const Epi& E) {
    const int tid = opaque_tid(), wid = __builtin_amdgcn_readfirstlane(tid >> 6), lane = tid & 63, wr = wid >> 2, wc = wid & 3, fr = lane & 15, fq = lane >> 4;
    const int K = g.K, nt = K / BK, lda = g.lda, ldb = g.ldb ? g.ldb : g.K;
    unsigned vA[2][2], vAn[2][2], vB[2]; int rA[2], cA2[2];
#pragma unroll
    for (int i = 0; i < 2; ++i) { int R, C; stage_rc(tid * 16 + i * 8192, R, C); const int Rb = Epi::PERM ? ((R & ~31) + perm32(R & 31)) : R;
        rA[i] = R; cA2[i] = C * 2;
        vA[0][i] = (unsigned)(R * lda + C) * 2u; vA[1][i] = (unsigned)((R + HALF) * lda + C) * 2u; vB[i] = (unsigned)(Rb * ldb + C) * 2u;
        vAn[0][i] = vA[0][i]; vAn[1][i] = vA[1][i]; }
    const size_t kstep = (size_t)(BK * 2);
    const size_t hstepB = (size_t)HALF * ldb * 2;
    const size_t tstepB = 2 * hstepB;
    const size_t tstepA = (size_t)BM * lda * 2;
    const unsigned ldsw = (unsigned)wid * 1024u;
    const int aoff = lds_byte(wr * 64 + fr, fq * 8), boff = lds_byte(wc * 32 + fr, fq * 8);
#define PG8_SA(b, h) (((b) * 2 + (h)) * HTB)
#define PG8_SB(b, h) ((4 + (b) * 2 + (h)) * HTB)
#define PG8_STAGE2(bufoff, gbase, o0, o1) do { \
        __builtin_amdgcn_global_load_lds((const unsigned*)((const char*)(gbase) + (o0)), (LAS unsigned*)(lds + (bufoff) + ldsw), 16, 0, 0); \
        __builtin_amdgcn_global_load_lds((const unsigned*)((const char*)(gbase) + (o1)), (LAS unsigned*)(lds + (bufoff) + ldsw + 8192), 16, 0, 0); } while (0)
#define PG8_STB(bufoff, gbase) PG8_STAGE2(bufoff, gbase, vB[0], vB[1])
#define PG8_STA(bufoff, gbase, h) PG8_STAGE2(bufoff, gbase, vA[h][0], vA[h][1])
#define PG8_LDA(dst, b, h) do { _Pragma("unroll") for (int m = 0; m < 4; ++m) _Pragma("unroll") for (int k = 0; k < 2; ++k) dst[m][k] = *(const LAS bf16x8*)(lds + PG8_SA(b, h) + aoff + m * 2048 + k * 1024); } while (0)
#define PG8_LDB(dst, b, h) do { _Pragma("unroll") for (int n = 0; n < 2; ++n) _Pragma("unroll") for (int k = 0; k < 2; ++k) dst[n][k] = *(const LAS bf16x8*)(lds + PG8_SB(b, h) + boff + n * 2048 + k * 1024); } while (0)
#define PG8_MMA(ai, bj, At, Bt) do { __builtin_amdgcn_s_setprio(1); _Pragma("unroll") for (int m = 0; m < 4; ++m) _Pragma("unroll") for (int n = 0; n < 2; ++n) _Pragma("unroll") for (int k = 0; k < 2; ++k) \
        acc[ai][bj][m][n] = __builtin_amdgcn_mfma_f32_16x16x32_bf16(Bt[n][k], At[m][k], acc[ai][bj][m][n], 0, 0, 0); __builtin_amdgcn_s_setprio(0); } while (0)
#define PG8_WAIT_V(n) asm volatile("s_waitcnt vmcnt(" #n ")" ::: "memory")
#define PG8_WAIT_L(n) asm volatile("s_waitcnt lgkmcnt(" #n ")" ::: "memory")
#define PG8_BAR __builtin_amdgcn_s_barrier()
#define PG8_SCHED __builtin_amdgcn_sched_barrier(0)
#define PG8_GIDX(dst, u) do { if constexpr (GATHER) { _Pragma("unroll") for (int h = 0; h < 2; ++h) _Pragma("unroll") for (int i = 0; i < 2; ++i) { \
        int tk = g.rowidx[(u).pm * BM + h * HALF + rA[i]]; tk = tk < 0 ? 0 : tk; dst[h][i] = (unsigned)tk * (unsigned)(lda * 2) + (unsigned)cA2[i]; } } } while (0)
    Unit cur, nxt; int ui = 0;
    if (!S.next(0, cur)) return;
    f32x4 acc[2][2][4][2];
#pragma unroll
    for (int a = 0; a < 2; ++a)
#pragma unroll
        for (int b = 0; b < 2; ++b)
#pragma unroll
            for (int m = 0; m < 4; ++m)
#pragma unroll
                for (int n = 0; n < 2; ++n) acc[a][b][m][n] = (f32x4){0.f, 0.f, 0.f, 0.f};
    bf16x8 At[4][2], B0[2][2], B1[2][2];
    const char* cA = GATHER ? (const char*)g.A : (const char*)g.A + (size_t)cur.pm * tstepA + cur.koff; const char* cB = (const char*)g.Bt + (size_t)cur.pn * tstepB + cur.koff;
    PG8_GIDX(vA, cur);
    PG8_STB(PG8_SB(0, 0), cB); PG8_STB(PG8_SB(0, 1), cB + hstepB); PG8_STA(PG8_SA(0, 0), cA, 0); PG8_STA(PG8_SA(0, 1), cA, 1);
    if (wr == 1) PG8_BAR;
    PG8_WAIT_V(2); PG8_BAR;
    PG8_STB(PG8_SB(1, 0), cB + kstep); PG8_STA(PG8_SA(1, 0), cA + kstep, 0); PG8_STB(PG8_SB(1, 1), cB + hstepB + kstep);
    PG8_WAIT_V(6); PG8_BAR;
    for (;;) {
        const bool has_next = S.next(ui + 1, nxt);
        const char* nA = GATHER ? cA : (has_next ? (const char*)g.A + (size_t)nxt.pm * tstepA + nxt.koff : cA); const char* nB = has_next ? (const char*)g.Bt + (size_t)nxt.pn * tstepB + nxt.koff : cB;
        if constexpr (GATHER) { if (has_next) { PG8_GIDX(vAn, nxt); } else {
#pragma unroll
            for (int h = 0; h < 2; ++h)
#pragma unroll
                for (int i = 0; i < 2; ++i) vAn[h][i] = vA[h][i]; } }
        const int ntu = cur.nt > 0 ? cur.nt : nt;
        for (int t = 0; t < ntu; t += 2) {
            const bool last = (t == ntu - 2);
            const char* a1 = cA + (size_t)(t + 1) * kstep;
            const char* a2 = last ? nA : cA + (size_t)(t + 2) * kstep; const char* b2 = last ? nB : cB + (size_t)(t + 2) * kstep;
            const char* a3 = a2 + kstep; const char* b3 = b2 + kstep;
            PG8_LDB(B0, 0, 0); PG8_LDB(B1, 0, 1); PG8_SCHED; PG8_LDA(At, 0, 0); PG8_STA(PG8_SA(1, 1), a1, 1);
            if constexpr (GATHER) { if (last) {
#pragma unroll
                for (int h = 0; h < 2; ++h)
#pragma unroll
                    for (int i = 0; i < 2; ++i) vA[h][i] = vAn[h][i]; } }
            PG8_WAIT_V(8); PG8_WAIT_L(0); PG8_BAR; PG8_MMA(0, 0, At, B0); PG8_MMA(0, 1, At, B1); PG8_BAR; PG8_SCHED;
            PG8_LDA(At, 0, 1); PG8_STB(PG8_SB(0, 0), b2); PG8_STB(PG8_SB(0, 1), b2 + hstepB); PG8_STA(PG8_SA(0, 0), a2, 0);
            PG8_WAIT_V(8); PG8_WAIT_L(0); PG8_BAR; PG8_MMA(1, 0, At, B0); PG8_MMA(1, 1, At, B1); PG8_BAR; PG8_SCHED;
            PG8_LDB(B0, 1, 0); PG8_LDB(B1, 1, 1); PG8_SCHED; PG8_LDA(At, 1, 0); PG8_STA(PG8_SA(0, 1), a2, 1);
            PG8_WAIT_V(8); PG8_WAIT_L(0); PG8_BAR; PG8_MMA(0, 0, At, B0); PG8_MMA(0, 1, At, B1); PG8_BAR; PG8_SCHED;
            PG8_LDA(At, 1, 1); PG8_STB(PG8_SB(1, 0), b3); PG8_STB(PG8_SB(1, 1), b3 + hstepB); PG8_STA(PG8_SA(1, 0), a3, 0);
            PG8_WAIT_V(8); PG8_WAIT_L(0); PG8_BAR; PG8_MMA(1, 0, At, B0); PG8_MMA(1, 1, At, B1); PG8_BAR; PG8_SCHED;
        }
        if constexpr (ALIGN_EPI) { if (wr == 0) PG8_BAR; }
        E(acc, cur, wr, wc, fr, fq);
        if (!has_next) break;
#pragma unroll
        for (int a = 0; a < 2; ++a)
#pragma unroll
            for (int b = 0; b < 2; ++b)
#pragma unroll
                for (int m = 0; m < 4; ++m)
#pragma unroll
                    for (int n = 0; n < 2; ++n) acc[a][b][m][n] = (f32x4){0.f, 0.f, 0.f, 0.f};
        cur = nxt; cA = nA; cB = nB; ++ui;
        if constexpr (ALIGN_EPI) { if (wr == 1) PG8_BAR; }
    }
    PG8_WAIT_V(0);
    if constexpr (!ALIGN_EPI) { if (wr == 0) PG8_BAR; }
    PG8_BAR;
#undef PG8_SA
#undef PG8_SB
#undef PG8_STAGE2
#undef PG8_STB
#undef PG8_STA
#undef PG8_LDA
#undef PG8_LDB
#undef PG8_MMA
#undef PG8_WAIT_V
#undef PG8_WAIT_L
#undef PG8_BAR
#undef PG8_SCHED
#undef PG8_GIDX
}
}

#define XB_TMO      128
#define XB_XCNT(j)  (256  + 64 * (j))
#define XB_XSUB(j)  (1280 + 64 * (j))
#define XB_XGEN(j)  (2304 + 64 * (j))
#define XB_TOP      3328
#define XB_TOPGEN   3392
#define XCD_BAR_WORDS 3456
#define XB_SPIN_CAP (1u << 18)
__device__ __forceinline__ unsigned xb_ld(unsigned* p)              { return __hip_atomic_load(p, __ATOMIC_RELAXED, __HIP_MEMORY_SCOPE_AGENT); }
__device__ __forceinline__ unsigned xb_add(unsigned* p, unsigned v) { return __hip_atomic_fetch_add(p, v, __ATOMIC_RELAXED, __HIP_MEMORY_SCOPE_AGENT); }
__device__ __forceinline__ unsigned xb_xcc_id() { return (unsigned)__builtin_amdgcn_s_getreg((3 << 11) | 20) & 0xFu; }
#define XB_SPIN(cond, bar) do { unsigned _sp = 0; while (cond) { __builtin_amdgcn_s_sleep(1); \
    if ((++_sp & 255u) == 0u) { if (xb_ld(&(bar)[XB_TMO])) break; if (_sp > XB_SPIN_CAP) { atomicAdd(&(bar)[XB_TMO], 1u); break; } } } } while (0)
struct XcdBarrier { unsigned* bar; unsigned x; volatile LAS unsigned* st; };
__device__ __forceinline__ XcdBarrier xcd_barrier_post(unsigned* bar, volatile LAS unsigned* st) {
    XcdBarrier b; b.bar = bar; b.x = xb_xcc_id(); b.st = st;
    if (threadIdx.x == 0) (void)xb_add(&bar[XB_XCNT(b.x)], 1u);
    return b;
}
__device__ __forceinline__ void xcd_barrier_complete(unsigned* bar, unsigned x, unsigned& nloc, unsigned& nx) {
    const unsigned G = gridDim.x * gridDim.y * gridDim.z;
    unsigned sum, cnt, mine, sp = 0u;
    for (;;) {
        sum = 0u; cnt = 0u; mine = 0u;
#pragma unroll
        for (unsigned j = 0; j < 16; ++j) { const unsigned c = xb_ld(&bar[XB_XCNT(j)]); sum += c; cnt += (c > 0u) ? 1u : 0u; mine = (j == x) ? c : mine; }
        if (sum == G) break;
        __builtin_amdgcn_s_sleep(1);
        if ((++sp & 255u) == 0u) { if (xb_ld(&bar[XB_TMO])) break; if (sp > XB_SPIN_CAP) { atomicAdd(&bar[XB_TMO], 1u); break; } }
    }
    nloc = mine > 0u ? mine : 1u; nx = cnt > 0u ? cnt : 1u;
}
__device__ __forceinline__ void xcd_barrier(const XcdBarrier& b) {
    asm volatile("s_waitcnt vmcnt(0)" ::: "memory");
    __syncthreads();
    if (threadIdx.x == 0) {
        unsigned* bar = b.bar;
        __builtin_amdgcn_s_waitcnt(0);
        unsigned nloc = b.st[0], nx = b.st[1];
        if (nloc == 0u) { xcd_barrier_complete(bar, b.x, nloc, nx); b.st[0] = nloc; b.st[1] = nx; }
        const unsigned old = xb_add(&bar[XB_XSUB(b.x)], 1u);
        const unsigned gen = old / nloc;
        if (old + 1u == (gen + 1u) * nloc) {
            __builtin_amdgcn_fence(__ATOMIC_RELEASE, "agent");
            asm volatile("s_waitcnt vmcnt(0)" ::: "memory");
            const unsigned og = xb_add(&bar[XB_TOP], 1u);
            const unsigned tg = og / nx;
            if (og + 1u == (tg + 1u) * nx) xb_add(&bar[XB_TOPGEN], 1u);
            else XB_SPIN(xb_ld(&bar[XB_TOPGEN]) == tg, bar);
            __builtin_amdgcn_fence(__ATOMIC_ACQUIRE, "agent");
            xb_add(&bar[XB_XGEN(b.x)], 1u);
            asm volatile("s_waitcnt vmcnt(0)" ::: "memory");
        } else {
            XB_SPIN(xb_ld(&bar[XB_XGEN(b.x)]) == gen, bar);
            __builtin_amdgcn_fence(__ATOMIC_ACQUIRE, "agent");
            asm volatile("s_waitcnt vmcnt(0)" ::: "memory");
        }
    }
    __syncthreads();
}

struct GridOrder {
    int nM, nN, nwg, G, c;
    __device__ __forceinline__ void init(int nM_, int nN_, int G_, int c_) { nM = nM_; nN = nN_; nwg = nM_ * nN_; G = G_; c = c_; }
    __device__ __forceinline__ bool next(int i, pg8::Unit& u) const {
        int L = i * G + c; if (L >= nwg) return false;
        const int nig = 8 * nN, gid = L / nig, fm = gid * 8, gsz = (nM - fm) < 8 ? (nM - fm) : 8, w = L % nig;
        u.pm = fm + (w % gsz); u.pn = w / gsz; u.koff = 0; u.nt = 0; return true;
    }
};
struct CmpOrder {
    int G, c;
    __device__ __forceinline__ bool next(int i, pg8::Unit& u) const { const int L = i * G + c; if (L >= 32) return false; u.pm = L; u.pn = L >> 4; u.koff = 0; u.nt = 0; return true; }
};
struct MoeOrder {
    int G, c, NJ, ntiles, nsplit; const LAS unsigned* tend;
    __device__ __forceinline__ bool next(int i, pg8::Unit& u) const {
        int L = i * G + c; const int nwg = ntiles * NJ; int rt, j;
        if (L < nwg) { const int nig = 8 * NJ, gid = L / nig, fm = gid * 8, gsz = (ntiles - fm) < 8 ? (ntiles - fm) : 8, w = L % nig; rt = fm + (w % gsz); j = w / gsz; u.koff = 0; u.nt = 0; }
        else { L -= nwg; if (L >= nsplit * 44) return false; const int ch = L % 11, rest = L / 11; j = rest & 3; rt = ntiles + (rest >> 2); u.koff = ch * 512; u.nt = 4; }
        int e = 0;
#pragma unroll
        for (int q = 0; q < 7; ++q) e += (rt >= (int)tend[q]) ? 1 : 0;
        u.pm = rt; u.pn = __builtin_amdgcn_readfirstlane(e) * NJ + j; return true;
    }
};

typedef const f32x4 (&AccRef)[2][2][4][2];
__device__ __forceinline__ u32x4 pack8(f32x4 a, f32x4 b) { u32x4 w; w.x = cvt_pk_bf16(a[0], a[1]); w.y = cvt_pk_bf16(a[2], a[3]); w.z = cvt_pk_bf16(b[0], b[1]); w.w = cvt_pk_bf16(b[2], b[3]); return w; }

template <int ACT> struct EpiPlain {
    static constexpr bool PERM = true;
    bf16_t* O; int ldc; const float* bias; int ncols_valid; int pn_mod;
    __device__ __forceinline__ void operator()(AccRef acc, const pg8::Unit& u, int wr, int wc, int fr, int fq) const {
        const int row0 = u.pm * 256 + wr * 64 + fr; const int colt = (u.pn % pn_mod) * 256;
#pragma unroll
        for (int bj = 0; bj < 2; ++bj) { const int col = colt + bj * 128 + wc * 32 + 8 * fq; if (col >= ncols_valid) continue;
            f32x4 b0 = (f32x4){0.f, 0.f, 0.f, 0.f}, b1 = b0;
            if (ACT == 1) { const float* bp = bias + u.pn * 256 + bj * 128 + wc * 32 + 8 * fq; b0 = *(const f32x4*)bp; b1 = *(const f32x4*)(bp + 4); }
#pragma unroll
            for (int ai = 0; ai < 2; ++ai)
#pragma unroll
                for (int m = 0; m < 4; ++m) { f32x4 v0 = acc[ai][bj][m][0], v1 = acc[ai][bj][m][1];
                    if (ACT == 1) { v0 += b0; v1 += b1;
#pragma unroll
                        for (int e = 0; e < 4; ++e) { v0[e] = silu_f(v0[e]); v1[e] = silu_f(v1[e]); } }
                    *(u32x4*)(O + (size_t)(row0 + ai * 128 + m * 16) * ldc + col) = pack8(v0, v1); } }
    }
};
struct EpiMix {
    static constexpr bool PERM = true;
    bf16_t* Q; unsigned char* SBK; unsigned char* SBV; unsigned char* NSAI; bf16_t* KC; float* GATE;
    __device__ __forceinline__ void operator()(AccRef acc, const pg8::Unit& u, int wr, int wc, int fr, int fq) const {
        const int row = u.pm * 256 + wr * 64 + fr; const int pn = u.pn;
        const int b = row >> 11, t = row & 2047, tile = t >> 6, key = t & 63;
        const float sc = (pn < 2 || pn == 6 || pn == 7) ? QSCALE : 1.0f;
#pragma unroll
        for (int bj = 0; bj < 2; ++bj) { const int cc = bj * 128 + wc * 32 + 8 * fq;
            unsigned char* base; int sm, sa = 16384; bool gate = false, skip = false;
            if (pn == 11) { gate = true; skip = cc >= 24; base = (unsigned char*)(GATE + (size_t)row * 32 + cc); sm = 2048; }
            else if (pn == 8) { const int which = cc >> 7, g = (cc >> 6) & 1, d = cc & 63; base = (unsigned char*)(KC + ((((size_t)(which * 16 + b) * 2 + g) * 2048 + t) * 64 + d)); sm = 2048; }
            else if (pn < 2 || pn == 6 || pn == 7) { const int col = (pn < 2 ? pn * 256 : 512 + (pn - 6) * 256) + cc; base = (unsigned char*)(Q + (size_t)row * DM + col); sm = 32768; sa = 262144; }
            else if (pn < 6) { const int ci = (pn & 1) * 256 + cc, h = ci >> 6, d0 = ci & 63; const size_t img = ((size_t)((b * 8 + h) * 32 + tile)) * 8192;
                if (pn < 4) { base = SBK + img + (d0 >> 3) * 1024 + key * 16; sm = 256; } else { base = SBV + img + (d0 >> 5) * 4096 + key * 64 + (d0 & 31) * 2; sm = 1024; } }
            else { const int isv = cc >> 7, g = (cc >> 6) & 1, d0 = cc & 63, wimg = (pn - 9) * 2 + isv; const size_t img = ((size_t)(((wimg * 16 + b) * 2 + g) * 32 + tile)) * 8192;
                if (!isv) { base = NSAI + img + (d0 >> 3) * 1024 + key * 16; sm = 256; } else { base = NSAI + img + (d0 >> 5) * 4096 + key * 64 + (d0 & 31) * 2; sm = 1024; } }
            if (skip) continue;
#pragma unroll
            for (int ai = 0; ai < 2; ++ai)
#pragma unroll
                for (int m = 0; m < 4; ++m) { f32x4 v0 = acc[ai][bj][m][0] * sc, v1 = acc[ai][bj][m][1] * sc; unsigned char* dp = base + m * sm + ai * sa;
                    if (gate) {
#pragma unroll
                        for (int e = 0; e < 4; ++e) { v0[e] = sigmoid_f(v0[e]); v1[e] = sigmoid_f(v1[e]); }
                        *(f32x4*)dp = v0; *(f32x4*)(dp + 16) = v1; }
                    else *(u32x4*)dp = pack8(v0, v1); } }
    }
};
struct EpiSwiGLU {
    static constexpr bool PERM = true;
    bf16_t* O; int ldc; int NJ;
    __device__ __forceinline__ void operator()(AccRef acc, const pg8::Unit& u, int wr, int wc, int fr, int fq) const {
        const int row0 = u.pm * 256 + wr * 64 + fr; const int col = (u.pn % NJ) * 128 + wc * 32 + 8 * fq;
#pragma unroll
        for (int ai = 0; ai < 2; ++ai)
#pragma unroll
            for (int m = 0; m < 4; ++m) { f32x4 v0, v1;
#pragma unroll
                for (int e = 0; e < 4; ++e) { v0[e] = silu_f(acc[ai][0][m][0][e]) * acc[ai][1][m][0][e]; v1[e] = silu_f(acc[ai][0][m][1][e]) * acc[ai][1][m][1][e]; }
                *(u32x4*)(O + (size_t)(row0 + ai * 128 + m * 16) * ldc + col) = pack8(v0, v1); }
    }
};
struct EpiConvIn {
    static constexpr bool PERM = true;
    bf16_t* Z; bf16_t* GB;
    __device__ __forceinline__ void operator()(AccRef acc, const pg8::Unit& u, int wr, int wc, int fr, int fq) const {
        const int row0 = u.pm * 256 + wr * 64 + fr;
        if (u.pn < 8) { const int col = u.pn * 128 + wc * 32 + 8 * fq;
#pragma unroll
            for (int ai = 0; ai < 2; ++ai)
#pragma unroll
                for (int m = 0; m < 4; ++m) *(u32x4*)(Z + (size_t)(row0 + ai * 128 + m * 16) * DM + col) = pack8(acc[ai][0][m][0] * acc[ai][1][m][0], acc[ai][0][m][1] * acc[ai][1][m][1]);
        } else {
#pragma unroll
            for (int bj = 0; bj < 2; ++bj) { const int col = (u.pn - 8) * 256 + bj * 128 + wc * 32 + 8 * fq;
#pragma unroll
                for (int ai = 0; ai < 2; ++ai)
#pragma unroll
                    for (int m = 0; m < 4; ++m) *(u32x4*)(GB + (size_t)(row0 + ai * 128 + m * 16) * DM + col) = pack8(acc[ai][bj][m][0], acc[ai][bj][m][1]); }
        }
    }
};
struct EpiMoeDown {
    static constexpr bool PERM = false;
    float* out; const int* rowtok; const float* rowgate; const float* g2;
    __device__ __forceinline__ void operator()(AccRef acc, const pg8::Unit& u, int wr, int wc, int fr, int fq) const {
        const int row0 = u.pm * 256 + wr * 64 + fr; const int colt = (u.pn & 3) * 256 + wc * 32 + 4 * fq; const bool ATOMIC = u.nt != 0;
#pragma unroll
        for (int ai = 0; ai < 2; ++ai)
#pragma unroll
            for (int m = 0; m < 4; ++m) { const int row = row0 + ai * 128 + m * 16; const int tok = rowtok[row]; if (tok < 0) continue;
                const float gt = rowgate[row]; const float* gp = g2 + (size_t)(tok >> 11) * 6144; float* op = out + (size_t)tok * DM;
#pragma unroll
                for (int bj = 0; bj < 2; ++bj)
#pragma unroll
                    for (int n = 0; n < 2; ++n) { const int col = colt + bj * 128 + n * 16; const f32x4 gg = *(const f32x4*)(gp + col); const f32x4 v = (gg + 1.0f) * gt * acc[ai][bj][m][n];
                        if (ATOMIC) {
#pragma unroll
                            for (int e = 0; e < 4; ++e) (void)__hip_atomic_fetch_add(op + col + e, v[e], __ATOMIC_RELAXED, __HIP_MEMORY_SCOPE_AGENT); }
                        else { f32x4 o = *(f32x4*)(op + col); o += v; *(f32x4*)(op + col) = o; } } }
    }
};

struct Args {
    const float *x, *c, *ada_w, *ada_b, *ln_g, *ln_b, *mix_w_in, *cmp_pos, *cmp_w1, *cmp_w2, *mix_w_out, *ffn_w1, *ffn_w3, *ffn_w2,
                *conv_w_in, *conv_taps, *conv_w_out, *router_w, *router_b, *exp_w1, *exp_w3, *exp_w2;
    float* out; unsigned char* ws;
};

__device__ __forceinline__ void transpose_item(const float* W, int N, int k0, int n0, bf16_t* WT, int dK, int drow0, LAS float* scr, int lane) {
    const int n = n0 + (lane & 31); const bool ok = n < N;
    float tv[32];
#pragma unroll
    for (int i = 0; i < 32; ++i) { const int kk = 2 * i + (lane >> 5); tv[i] = ok ? W[(size_t)(k0 + kk) * N + n] : 0.f; }
#pragma unroll
    for (int i = 0; i < 32; ++i) { const int kk = 2 * i + (lane >> 5); scr[kk * 33 + (lane & 31)] = tv[i]; }
    asm volatile("s_waitcnt lgkmcnt(0)" ::: "memory");
    const int c = lane & 7;
#pragma unroll
    for (int j = 0; j < 4; ++j) { const int nn = (lane >> 3) + 8 * j; const LAS float* s = scr + (8 * c) * 33 + nn;
        u32x4 o; o.x = cvt_pk_bf16(s[0 * 33], s[1 * 33]); o.y = cvt_pk_bf16(s[2 * 33], s[3 * 33]); o.z = cvt_pk_bf16(s[4 * 33], s[5 * 33]); o.w = cvt_pk_bf16(s[6 * 33], s[7 * 33]);
        *(u32x4*)(WT + (size_t)(drow0 + nn) * dK + k0 + 8 * c) = o; }
    asm volatile("s_waitcnt lgkmcnt(0)" ::: "memory");
}
__device__ __forceinline__ int il1(int n) { return (n >> 7) * 256 + (n & 127); }
__device__ __forceinline__ void weight_item(const Args& a, int it, LAS float* scr, int lane) {
    unsigned char* ws = a.ws;
#define WITEM(cnt, SRC, KK, NN, NBLK, DST, MODE, ROFF) if (it < (cnt)) { const int bi_ = it >> 3, kb = bi_ % ((KK) / 64), nb = (bi_ / ((KK) / 64)) * 8 + (it & 7), n0 = nb * 32; int dr; \
        if ((MODE) == 0) dr = n0; else if ((MODE) == 1) dr = il1(n0); else if ((MODE) == 2) dr = il1(n0) + 128; \
        else dr = (n0 < 1024) ? 2048 + n0 : ((n0 < 2048) ? il1(n0 - 1024) : il1(n0 - 2048) + 128); \
        transpose_item((SRC), (NN), kb * 64, n0, (bf16_t*)(DST), (KK), dr + (ROFF), scr, lane); return; } it -= (cnt);
    WITEM(1536, a.mix_w_in, 1024, MIXN, 96, ws + W_MIX, 0, 0)
    WITEM(512, a.mix_w_out, 1024, 1024, 32, ws + W_OUT, 0, 0)
    WITEM(1408, a.ffn_w1, 1024, DFF, 88, ws + W_F13, 1, 0)
    WITEM(1408, a.ffn_w3, 1024, DFF, 88, ws + W_F13, 2, 0)
    WITEM(1408, a.ffn_w2, DFF, 1024, 32, ws + W_F2, 0, 0)
    WITEM(1536, a.conv_w_in, 1024, 3072, 96, ws + W_CIN, 3, 0)
    WITEM(512, a.conv_w_out, 1024, 1024, 32, ws + W_COUT, 0, 0)
    { const int e = it / 1408; if (e < 8) { int it2 = it % 1408; const int bi_ = it2 >> 3, kb = bi_ % 16, nb = (bi_ / 16) * 8 + (it2 & 7), n0 = nb * 32;
        transpose_item(a.exp_w1 + (size_t)e * 1024 * DFF, DFF, kb * 64, n0, (bf16_t*)(ws + W_E13), 1024, il1(n0) + e * 2 * DFF, scr, lane); return; } it -= 8 * 1408; }
    { const int e = it / 1408; if (e < 8) { int it2 = it % 1408; const int bi_ = it2 >> 3, kb = bi_ % 16, nb = (bi_ / 16) * 8 + (it2 & 7), n0 = nb * 32;
        transpose_item(a.exp_w3 + (size_t)e * 1024 * DFF, DFF, kb * 64, n0, (bf16_t*)(ws + W_E13), 1024, il1(n0) + 128 + e * 2 * DFF, scr, lane); return; } it -= 8 * 1408; }
    { const int e = it / 1408; if (e < 8) { int it2 = it % 1408; const int bi_ = it2 >> 3, kb = bi_ % 44, nb = (bi_ / 44) * 8 + (it2 & 7), n0 = nb * 32;
        transpose_item(a.exp_w2 + (size_t)e * DFF * 1024, 1024, kb * 64, n0, (bf16_t*)(ws + W_E2), DFF, n0 + e * 1024, scr, lane); return; } it -= 8 * 1408; }
    { const int w = it / 256; if (w < 2) { int it2 = it % 256; const int kb = it2 >> 3, nb = it2 & 7, n0 = nb * 32;
        transpose_item(a.cmp_w1 + (size_t)w * 2048 * 256, 256, kb * 64, n0, (bf16_t*)(ws + W_C1), 2048, n0 + w * 256, scr, lane); return; } it -= 512; }
    { const int w = it / 32; if (w < 2) { int it2 = it % 32; const int kb = it2 >> 3, nb = it2 & 7, n0 = nb * 32;
        transpose_item(a.cmp_w2 + (size_t)w * 256 * 64, 64, kb * 64, n0, (bf16_t*)(ws + W_C2), 256, n0 + w * 256, scr, lane); return; } }
#undef WITEM
}
constexpr int N_WITEMS = 1536 + 512 + 1408 * 3 + 1536 + 512 + 3 * 8 * 1408 + 512 + 64;

template <int NB>
__device__ __forceinline__ void gemv_block(LAS float* sv, LAS float* part, const float* W, int K, int N, int j0, const float* bias, float* out, int out_pitch, int tid) {
    const int wid = tid >> 6, lane = tid & 63, kc = K / 8, kb = wid * kc;
    float acc[NB];
#pragma unroll
    for (int b = 0; b < NB; ++b) acc[b] = 0.f;
    const float* wp = W + (size_t)kb * N + j0 + lane;
    for (int k0 = 0; k0 < kc; k0 += 16) {
        float wv[16];
#pragma unroll
        for (int j = 0; j < 16; ++j) wv[j] = wp[(size_t)(k0 + j) * N];
#pragma unroll
        for (int j = 0; j < 16; ++j)
#pragma unroll
            for (int b = 0; b < NB; ++b) acc[b] += sv[b * K + kb + k0 + j] * wv[j]; }
#pragma unroll
    for (int b = 0; b < NB; ++b) part[(wid * NB + b) * 64 + lane] = acc[b];
    __syncthreads();
    for (int idx = tid; idx < NB * 64; idx += 512) { const int b = idx >> 6, l = idx & 63; float s = 0.f;
#pragma unroll
        for (int w = 0; w < 8; ++w) s += part[(w * NB + b) * 64 + l];
        if (bias) s += bias[j0 + l];
        out[(size_t)b * out_pitch + j0 + l] = s; }
    __syncthreads();
}

__device__ __forceinline__ void phase_prologue(const Args& a, LAS unsigned char* lds, int tid) {
    const int wid = tid >> 6, lane = tid & 63, G = gridDim.x, bx = blockIdx.x;
    LAS float* sv = (LAS float*)lds;
    LAS float* part = (LAS float*)(lds + 65536);
    float* MOD = (float*)(a.ws + WS_MOD); float* CB = (float*)(a.ws + WS_CBIAS);
    bool have_silu = false;
    __syncthreads();
    for (int item = bx; item < 200; item += G) {
        if (item < 192) {
            if (!have_silu) { for (int i = tid; i < 16 * 1024; i += 512) sv[i] = silu_f(a.c[i]); __syncthreads(); have_silu = true; }
            const int li = item / 96, jg = item % 96;
            gemv_block<16>(sv, part, a.ada_w + (size_t)li * 1024 * 6144, 1024, 6144, jg * 64, a.ada_b + li * 6144, MOD + (size_t)li * 16 * 6144, 6144, tid);
        } else {
            const int q = item - 192, w = q >> 2, jg = q & 3;
            __syncthreads();
            for (int i = tid; i < 2048; i += 512) sv[i] = a.cmp_pos[w * 2048 + i];
            __syncthreads(); have_silu = false;
            gemv_block<1>(sv, part, a.cmp_w1 + (size_t)w * 2048 * 256, 2048, 256, jg * 64, nullptr, CB + w * 256, 256, tid);
        }
    }
    __syncthreads();
    if (bx == G - 1) for (int i = tid; i < 65536 / 16; i += 512) *(u32x4*)(a.ws + R3_KCPAD + (size_t)i * 16) = (u32x4){0u, 0u, 0u, 0u};
    LAS float* scr = (LAS float*)(lds + wid * 16384);
    { constexpr int NBI = N_WITEMS / 8; unsigned* head = (unsigned*)(a.ws + WS_CTL) + CW_WQ + 256; volatile LAS unsigned* wqw = (volatile LAS unsigned*)(lds + MISC_OFF + 128);
      for (;;) { __syncthreads(); if (tid == 0) *wqw = atomicAdd(head, 1u); __syncthreads(); const int bi = (int)*wqw; if (bi >= NBI) break;
          weight_item(a, bi * 8 + wid, scr, lane); } }
}

__device__ __forceinline__ void phase_modulate(const float* x, const float* sc, const float* sh, bf16_t* h, int tid) {
    const int wid = tid >> 6, lane = tid & 63;
    for (int row = blockIdx.x * 8 + wid; row < MTOK; row += gridDim.x * 8) { const int b = row >> 11;
#pragma unroll
        for (int j = 0; j < 4; ++j) { const int c = 4 * lane + 256 * j; const f32x4 v = *(const f32x4*)(x + (size_t)row * DM + c);
            const f32x4 s = *(const f32x4*)(sc + b * 6144 + c), t = *(const f32x4*)(sh + b * 6144 + c); const f32x4 o = v * (s + 1.0f) + t;
            u32x2 w; w.x = cvt_pk_bf16(o[0], o[1]); w.y = cvt_pk_bf16(o[2], o[3]); *(u32x2*)(h + (size_t)row * DM + c) = w; } }
}
template <bool HAS_Y, bool HAS_H, bool ROUTER>
__device__ __forceinline__ void phase_ln(const float* xin, float xscale, float oscale, const bf16_t* y, const float* gate, const float* lg, const float* lb, float* xout,
                                         bf16_t* hout, const float* sc, const float* sh, const float* rw, const float* rb, unsigned* ecnt, int* asg, float* agate, int tid) {
    const int wid = tid >> 6, lane = tid & 63;
    for (int row = blockIdx.x * 8 + wid; row < MTOK; row += gridDim.x * 8) { const int b = row >> 11;
        f32x4 v[4]; float s = 0.f;
#pragma unroll
        for (int j = 0; j < 4; ++j) { const int c = 4 * lane + 256 * j; v[j] = *(const f32x4*)(xin + (size_t)row * DM + c) * xscale;
            if (HAS_Y) { const u32x2 yw = *(const u32x2*)(y + (size_t)row * DM + c); const f32x4 gg = *(const f32x4*)(gate + b * 6144 + c);
                const f32x4 yv = (f32x4){bflo(yw.x), bfhi(yw.x), bflo(yw.y), bfhi(yw.y)}; v[j] += (gg + 1.0f) * yv; }
            s += (v[j][0] + v[j][1]) + (v[j][2] + v[j][3]); }
        const float mean = wave_sum(s) * (1.0f / DM); float s2 = 0.f;
#pragma unroll
        for (int j = 0; j < 4; ++j) { v[j] = v[j] - mean; s2 += (v[j][0] * v[j][0] + v[j][1] * v[j][1]) + (v[j][2] * v[j][2] + v[j][3] * v[j][3]); }
        const float rstd = 1.0f / sqrtf(wave_sum(s2) * (1.0f / DM) + LN_EPS);
        float lgt[8];
#pragma unroll
        for (int e = 0; e < 8; ++e) lgt[e] = 0.f;
#pragma unroll
        for (int j = 0; j < 4; ++j) { const int c = 4 * lane + 256 * j; const f32x4 g4 = *(const f32x4*)(lg + c), b4 = *(const f32x4*)(lb + c);
            const f32x4 xo = v[j] * rstd * g4 + b4; *(f32x4*)(xout + (size_t)row * DM + c) = xo * oscale;
            if (HAS_H) { const f32x4 s4 = *(const f32x4*)(sc + b * 6144 + c), t4 = *(const f32x4*)(sh + b * 6144 + c); const f32x4 hv = xo * (s4 + 1.0f) + t4;
                u32x2 w; w.x = cvt_pk_bf16(hv[0], hv[1]); w.y = cvt_pk_bf16(hv[2], hv[3]); *(u32x2*)(hout + (size_t)row * DM + c) = w;
                if (ROUTER) {
#pragma unroll
                    for (int q = 0; q < 4; ++q) { const f32x4 r0 = *(const f32x4*)(rw + (size_t)(c + q) * 8), r1 = *(const f32x4*)(rw + (size_t)(c + q) * 8 + 4);
#pragma unroll
                        for (int e = 0; e < 4; ++e) { lgt[e] += hv[q] * r0[e]; lgt[4 + e] += hv[q] * r1[e]; } } } } }
        if (ROUTER) {
#pragma unroll
            for (int e = 0; e < 8; ++e) lgt[e] = wave_sum(lgt[e]) + rb[e];
            int i1 = 0; float l1 = lgt[0];
#pragma unroll
            for (int e = 1; e < 8; ++e) if (lgt[e] > l1) { l1 = lgt[e]; i1 = e; }
            int i2 = -1; float l2 = -3.0e38f;
#pragma unroll
            for (int e = 0; e < 8; ++e) if (e != i1 && lgt[e] > l2) { l2 = lgt[e]; i2 = e; }
            const float ex = __expf(l2 - l1), den = 1.0f / (1.0f + ex);
            if (lane == 0) {
                const unsigned r1 = atomicAdd(ecnt + 64 * i1, 1u), r2 = atomicAdd(ecnt + 64 * (8 + i2), 1u);
                asg[row] = (i1 << 20) | (int)r1; asg[MTOK + row] = (i2 << 20) | (int)r2; agate[row] = den; agate[MTOK + row] = ex * den; }
        }
    }
}
__device__ __forceinline__ void phase_conv(const bf16_t* Z, const bf16_t* GB, const float* taps, bf16_t* A, int tid) {
    const int wid = tid >> 6, lane = tid & 63;
    for (int row = blockIdx.x * 8 + wid; row < MTOK; row += gridDim.x * 8) { const int t = row & 2047;
#pragma unroll
        for (int j = 0; j < 2; ++j) { const int c = 8 * lane + 512 * j;
            const u32x4 z2 = *(const u32x4*)(Z + (size_t)row * DM + c), gb = *(const u32x4*)(GB + (size_t)row * DM + c);
            u32x4 z1 = (u32x4){0u, 0u, 0u, 0u}, z0 = z1;
            if (t >= 1) z1 = *(const u32x4*)(Z + (size_t)(row - 1) * DM + c);
            if (t >= 2) z0 = *(const u32x4*)(Z + (size_t)(row - 2) * DM + c);
            u32x4 o;
#pragma unroll
            for (int q = 0; q < 4; ++q) { const int cc = c + 2 * q;
                const float a0 = bflo(gb[q]) * (taps[cc] * bflo(z0[q]) + taps[1024 + cc] * bflo(z1[q]) + taps[2048 + cc] * bflo(z2[q]));
                const float a1 = bfhi(gb[q]) * (taps[cc + 1] * bfhi(z0[q]) + taps[1024 + cc + 1] * bfhi(z1[q]) + taps[2048 + cc + 1] * bfhi(z2[q]));
                o[q] = cvt_pk_bf16(a0, a1); }
            *(u32x4*)(A + (size_t)row * DM + c) = o; } }
}
__device__ __forceinline__ void phase_moe_rows(unsigned char* ws, int tid) {
    unsigned* ctl = (unsigned*)(ws + WS_CTL); const int* asg = (const int*)(ws + WS_ASG); const float* agate = (const float*)(ws + WS_AGATE);
    int* rowtok = (int*)(ws + WS_ROWTOK); float* rowgate = (float*)(ws + WS_ROWGATE);
    int cnt[2][8], pst[2][8];
#pragma unroll
    for (int k = 0; k < 2; ++k) { int run = 0;
#pragma unroll
        for (int e = 0; e < 8; ++e) { cnt[k][e] = (int)xb_ld(ctl + CW_ECNT + 64 * (8 * k + e)); pst[k][e] = run; run += ((cnt[k][e] + 255) >> 8) << 8; } }
    const int gt = blockIdx.x * 512 + tid, GT = gridDim.x * 512;
    for (int idx = gt; idx < 2 * MTOK; idx += GT) { const int k = idx >= MTOK ? 1 : 0, tok = idx - k * MTOK; const int a = asg[idx], e = a >> 20, rk = a & 0xfffff;
        int ps = 0;
#pragma unroll
        for (int q = 0; q < 8; ++q) ps = (q == e) ? pst[k][q] : ps;
        const int row = ps + rk; rowtok[k * MOE_ROWS + row] = tok; rowgate[k * MOE_ROWS + row] = agate[idx]; }
    for (int idx = gt; idx < 2 * 8 * 256; idx += GT) { const int k = idx >> 11, e = (idx >> 8) & 7, q = idx & 255; int c = 0, ps = 0;
#pragma unroll
        for (int w = 0; w < 8; ++w) { c = (w == e) ? cnt[k][w] : c; ps = (w == e) ? pst[k][w] : ps; }
        const int row = ps + c + q, end = ps + (((c + 255) >> 8) << 8);
        if (row < end) { rowtok[k * MOE_ROWS + row] = -1; rowgate[k * MOE_ROWS + row] = 0.f; } }
    if (blockIdx.x == 0 && tid < 16) { const int k = tid >> 3, e = tid & 7; int te = 0;
#pragma unroll
        for (int w = 0; w < 8; ++w) if (w <= e) te += (cnt[k][w] + 255) >> 8;
        ctl[CW_TEND + 8 * k + e] = (unsigned)te; }
}

typedef short v4i16_t __attribute__((ext_vector_type(4)));
__device__ __forceinline__ f32x16 mfma32(bf16x8 a, bf16x8 b, f32x16 c) { return __builtin_amdgcn_mfma_f32_32x32x16_bf16(a, b, c, 0, 0, 0); }
__device__ __forceinline__ int crow(int r, int hi) { return (r & 3) + 8 * (r >> 2) + 4 * hi; }
__device__ __forceinline__ float xhalf_max(float v) { auto rr = __builtin_amdgcn_permlane32_swap(__float_as_uint(v), __float_as_uint(v), false, false); return fmaxf(__uint_as_float(rr[0]), __uint_as_float(rr[1])); }
__device__ __forceinline__ float xhalf_sum(float v) { auto rr = __builtin_amdgcn_permlane32_swap(__float_as_uint(v), __float_as_uint(v), false, false); return __uint_as_float(rr[0]) + __uint_as_float(rr[1]); }
struct KVStage { u32x4 k, v; };
__device__ __forceinline__ void kv_load(KVStage& s, const bf16_t* Kg, const bf16_t* Vg, int pitch, int key0, int wid, int lane) {
    s.k = *(const u32x4*)(Kg + (size_t)(key0 + lane) * pitch + wid * 8);
    s.v = *(const u32x4*)(Vg + (size_t)(key0 + 16 * (wid & 3) + (lane >> 2)) * pitch + (wid >> 2) * 32 + (lane & 3) * 8);
}
__device__ __forceinline__ void kv_store(const KVStage& s, LAS unsigned char* buf, int wid, int lane) {
    *(LAS u32x4*)(buf + wid * 1024 + lane * 16) = s.k;
    *(LAS u32x4*)(buf + 8192 + wid * 1024 + lane * 16) = s.v;
}
__device__ __forceinline__ void qk_tile(f32x16& s0, f32x16& s1, const LAS unsigned char* kb, const bf16x8 (&qr)[4], int r32, int hi) {
    s0 = (f32x16){}; s1 = (f32x16){};
#pragma unroll
    for (int d0 = 0; d0 < 4; ++d0) { const LAS unsigned char* p = kb + (2 * d0 + hi) * 1024 + r32 * 16;
        const bf16x8 k0 = *(const LAS bf16x8*)p, k1 = *(const LAS bf16x8*)(p + 512);
        s0 = mfma32(k0, qr[d0], s0); s1 = mfma32(k1, qr[d0], s1); }
}
__device__ __forceinline__ void pack_p(bf16x8 (&pb)[4], const f32x16& p0, const f32x16& p1) {
    u32x4 w;
    w.x = cvt_pk_bf16(p0[0], p0[1]); w.y = cvt_pk_bf16(p0[2], p0[3]); w.z = cvt_pk_bf16(p0[4], p0[5]); w.w = cvt_pk_bf16(p0[6], p0[7]); pb[0] = __builtin_bit_cast(bf16x8, w);
    w.x = cvt_pk_bf16(p0[8], p0[9]); w.y = cvt_pk_bf16(p0[10], p0[11]); w.z = cvt_pk_bf16(p0[12], p0[13]); w.w = cvt_pk_bf16(p0[14], p0[15]); pb[1] = __builtin_bit_cast(bf16x8, w);
    w.x = cvt_pk_bf16(p1[0], p1[1]); w.y = cvt_pk_bf16(p1[2], p1[3]); w.z = cvt_pk_bf16(p1[4], p1[5]); w.w = cvt_pk_bf16(p1[6], p1[7]); pb[2] = __builtin_bit_cast(bf16x8, w);
    w.x = cvt_pk_bf16(p1[8], p1[9]); w.y = cvt_pk_bf16(p1[10], p1[11]); w.z = cvt_pk_bf16(p1[12], p1[13]); w.w = cvt_pk_bf16(p1[14], p1[15]); pb[3] = __builtin_bit_cast(bf16x8, w);
}
__device__ __forceinline__ void pv_tile(f32x16& o0, f32x16& o1, const LAS unsigned char* vbuf, const bf16x8 (&pb)[4], int lane) {
    const int i = lane & 15, hi = lane >> 5;
    const LAS unsigned char* vb = vbuf + ((lane >> 4) & 1) * 32 + (i & 3) * 8 + (4 * hi + (i >> 2)) * 64;
#pragma unroll
    for (int ks = 0; ks < 4; ++ks) {
        const v4i16_t a0 = __builtin_amdgcn_ds_read_tr16_b64_v4i16((LAS v4i16_t*)(vb + ks * 1024));
        const v4i16_t a1 = __builtin_amdgcn_ds_read_tr16_b64_v4i16((LAS v4i16_t*)(vb + ks * 1024 + 512));
        const v4i16_t c0 = __builtin_amdgcn_ds_read_tr16_b64_v4i16((LAS v4i16_t*)(vb + 4096 + ks * 1024));
        const v4i16_t c1 = __builtin_amdgcn_ds_read_tr16_b64_v4i16((LAS v4i16_t*)(vb + 4096 + ks * 1024 + 512));
        const bf16x8 va = (bf16x8){a0[0], a0[1], a0[2], a0[3], a1[0], a1[1], a1[2], a1[3]};
        const bf16x8 vc = (bf16x8){c0[0], c0[1], c0[2], c0[3], c1[0], c1[1], c1[2], c1[3]};
        o0 = mfma32(va, pb[ks], o0); o1 = mfma32(vc, pb[ks], o1); }
}
__device__ __forceinline__ void store_ot(LAS unsigned char* stg, const f32x16& o0, const f32x16& o1, bf16_t* Og, int pitch, int lane) {
    const int r32 = lane & 31, hi = lane >> 5;
#pragma unroll
    for (int r = 0; r < 16; r += 2) { const int d = crow(r, hi);
        *(LAS unsigned*)(stg + r32 * 128 + d * 2) = cvt_pk_bf16(o0[r], o0[r + 1]);
        *(LAS unsigned*)(stg + r32 * 128 + 64 + d * 2) = cvt_pk_bf16(o1[r], o1[r + 1]); }
    asm volatile("s_waitcnt lgkmcnt(0)" ::: "memory");
#pragma unroll
    for (int i = 0; i < 4; ++i) { const int row = i * 8 + (lane >> 3), ch = lane & 7; const u32x4 v = *(const LAS u32x4*)(stg + row * 128 + ch * 16);
        *(u32x4*)(Og + (size_t)row * pitch + ch * 8) = v; }
    asm volatile("s_waitcnt lgkmcnt(0)" ::: "memory");
}

#define CK(a, r) (32 * (a) + ((r) & 3) + 8 * ((r) >> 2))
constexpr int ATT_RING = 0, ATT_SLOT = 16384, ATT_IMP = 65536, ATT_SEL = ATT_IMP + 4 * 64 * 33 * 4, ATT_DONE = ATT_SEL + 256, ATT_WQ = ATT_DONE + 64;
__device__ __forceinline__ int wq_next(unsigned* head, LAS unsigned char* lds, int tid) {
    __syncthreads();
    if (tid == 0) *(volatile LAS unsigned*)(lds + ATT_WQ) = atomicAdd(head, 1u);
    __syncthreads();
    return (int)*(volatile LAS unsigned*)(lds + ATT_WQ);
}
__device__ __forceinline__ void glds16(const void* gsrc, unsigned lds_dst) { unsigned keep;
    asm volatile("s_mov_b32 %0, m0\n\ts_mov_b32 m0, %2\n\ts_nop 0\n\tglobal_load_lds_dwordx4 %1, off\n\ts_mov_b32 m0, %0" : "=&s"(keep) : "v"(gsrc), "s"(lds_dst) : "memory"); }
__device__ __forceinline__ void kv_dma(LAS unsigned char* slot, const bf16_t* Kg, const bf16_t* Vg, int pitch, int key0, int wid, int lane) {
    const bf16_t* kp = Kg + (size_t)(key0 + lane) * pitch + wid * 8;
    const bf16_t* vp = Vg + (size_t)(key0 + 16 * (wid & 3) + (lane >> 2)) * pitch + (wid >> 2) * 32 + (lane & 3) * 8;
    const unsigned dst = (unsigned)__builtin_amdgcn_readfirstlane((int)(unsigned)(uintptr_t)(slot + wid * 1024));
    glds16(kp, dst); glds16(vp, dst + 8192u);
}
__device__ __forceinline__ void kv_dma_img(LAS unsigned char* slot, const unsigned char* Kimg, const unsigned char* Vimg, int wid, int lane) {
    const unsigned dst = (unsigned)__builtin_amdgcn_readfirstlane((int)(unsigned)(uintptr_t)(slot + wid * 1024));
    glds16(Kimg + wid * 1024 + lane * 16, dst); glds16(Vimg + wid * 1024 + lane * 16, dst + 8192u);
}
__device__ __forceinline__ void wait_bar(int ny) {
    if (ny >= 2) asm volatile("s_waitcnt vmcnt(4) lgkmcnt(0)\n\ts_barrier" ::: "memory");
    else if (ny == 1) asm volatile("s_waitcnt vmcnt(2) lgkmcnt(0)\n\ts_barrier" ::: "memory");
    else asm volatile("s_waitcnt vmcnt(0) lgkmcnt(0)\n\ts_barrier" ::: "memory");
}

constexpr float SB_DONE = 160.0f;
__device__ __forceinline__ void sb_unit(LAS unsigned char* lds, const bf16_t* Q, const unsigned char* SBK, const unsigned char* SBV, bf16_t* O, int b, int h, int qb, int wid, int lane) {
    const int r32 = lane & 31, hi = lane >> 5;
    const int qw = qb * 256 + wid * 32, tq = qw + r32;
    const bf16_t* Qp = Q + (size_t)(b * SEQ + tq) * DM + h * 64;
    bf16x8 qr[4];
#pragma unroll
    for (int d0 = 0; d0 < 4; ++d0) qr[d0] = *(const bf16x8*)(Qp + d0 * 16 + hi * 8);
    asm volatile("" : "+v"(qr[0]), "+v"(qr[1]), "+v"(qr[2]), "+v"(qr[3]));
    const unsigned char* Kimg = SBK + (size_t)((b * 8 + h) * 32) * 8192; const unsigned char* Vimg = SBV + (size_t)((b * 8 + h) * 32) * 8192;
    f32x16 o0 = (f32x16){}, o1 = (f32x16){}; float C = 0.f;
    const int nel = 4 * (qb + 1);
    LAS unsigned char* ring = lds + ATT_RING; LAS unsigned* DONE = (LAS unsigned*)(lds + ATT_DONE);
#pragma unroll
    for (int e = 0; e < 3; ++e) if (e < nel) kv_dma_img(ring + e * ATT_SLOT, Kimg + (size_t)(nel - 1 - e) * 8192, Vimg + (size_t)(nel - 1 - e) * 8192, wid, lane);
    bool wdone = false;
    for (int i = 0; i < nel; ++i) {
        const int jt = nel - 1 - i; const int li = (i + 2 < nel - 1) ? i + 2 : nel - 1;
        wait_bar(li - i);
        if (i > 0) { const unsigned f = DONE[(i & 1) * 8 + (lane & 7)]; if (__all(f != 0u)) break; }
        if (i + 3 < nel) kv_dma_img(ring + ((i + 3) & 3) * ATT_SLOT, Kimg + (size_t)(nel - 4 - i) * 8192, Vimg + (size_t)(nel - 4 - i) * 8192, wid, lane);
        const LAS unsigned char* buf = ring + (i & 3) * ATT_SLOT;
        if (!wdone && 64 * jt <= qw + 30) {
            f32x16 s0, s1; qk_tile(s0, s1, buf, qr, r32, hi);
            u32x4 wh[4], wl[4]; f32x2 tot2 = (f32x2){0.f, 0.f}; float tot;
            const int lim = tq - 64 * jt - 4 * hi;
#define SB_SPLUS(z) (fmaxf((z), 0.f) + fast_log2(1.0f + fast_exp2(-fabsf(z))))
#define SB_HI(x) __uint_as_float(__float_as_uint(x) & 0xffff0000u)
#define SB_PAIR(S, A, r, MASKED) do { float pa_ = SB_SPLUS(S[r]), pb2_ = SB_SPLUS(S[(r) + 1]); \
                if (MASKED) { const bool va_ = CK((A), (r)) < lim, vb_ = CK((A), (r) + 1) < lim; S[r] = va_ ? S[r] - pa_ : -1.0e30f; S[(r) + 1] = vb_ ? S[(r) + 1] - pb2_ : -1.0e30f; pa_ = va_ ? pa_ : 0.f; pb2_ = vb_ ? pb2_ : 0.f; } \
                else { S[r] -= pa_; S[(r) + 1] -= pb2_; } \
                tot2 += (f32x2){pa_, pb2_}; \
                wh[2 * (A) + ((r) >> 3)][((r) >> 1) & 3] = (__float_as_uint(pa_) >> 16) | (__float_as_uint(pb2_) & 0xffff0000u); \
                wl[2 * (A) + ((r) >> 3)][((r) >> 1) & 3] = cvt_pk_bf16(pa_ - SB_HI(pa_), pb2_ - SB_HI(pb2_)); } while (0)
            if (64 * jt + 63 < qw) {
#pragma unroll
                for (int r = 0; r < 16; r += 2) { SB_PAIR(s0, 0, r, false); SB_PAIR(s1, 1, r, false); }
            } else {
#pragma unroll
                for (int r = 0; r < 16; r += 2) { SB_PAIR(s0, 0, r, true); SB_PAIR(s1, 1, r, true); }
            }
#undef SB_PAIR
#undef SB_HI
#undef SB_SPLUS
            tot = tot2[0] + tot2[1];
            bf16x8 bh[4], bl[4];
#pragma unroll
            for (int q = 0; q < 4; ++q) { bh[q] = __builtin_bit_cast(bf16x8, wh[q]); bl[q] = __builtin_bit_cast(bf16x8, wl[q]); }
            bf16x8 tri[2], ones;
            { int rr = r32 - 4 * hi; asm volatile("" : "+v"(rr)); unsigned ou = 0x3F803F80u; asm volatile("" : "+v"(ou));
#pragma unroll
              for (int s2 = 0; s2 < 2; ++s2) { u32x4 w;
#pragma unroll
                  for (int q = 0; q < 4; ++q) { const int k0 = 16 * s2 + 8 * (q >> 1) + 2 * (q & 1);
                      w[q] = ((k0 > rr) ? 0x3F80u : 0u) | ((k0 + 1 > rr) ? 0x3F800000u : 0u); }
                  tri[s2] = __builtin_bit_cast(bf16x8, w); }
              ones = __builtin_bit_cast(bf16x8, (u32x4){ou, ou, ou, ou}); }
            f32x16 L0, L1;
#pragma unroll
            for (int r = 0; r < 16; ++r) { L0[r] = C; L1[r] = C; }
            L0 = mfma32(tri[0], bh[0], L0); L0 = mfma32(tri[0], bl[0], L0); L0 = mfma32(tri[1], bh[1], L0); L0 = mfma32(tri[1], bl[1], L0);
            L0 = mfma32(ones, bh[2], L0); L0 = mfma32(ones, bl[2], L0); L0 = mfma32(ones, bh[3], L0); L0 = mfma32(ones, bl[3], L0);
            L1 = mfma32(tri[0], bh[2], L1); L1 = mfma32(tri[0], bl[2], L1); L1 = mfma32(tri[1], bh[3], L1); L1 = mfma32(tri[1], bl[3], L1);
            C += xhalf_sum(tot);
#pragma unroll
            for (int r = 0; r < 16; ++r) { s0[r] = fast_exp2(s0[r] - L0[r]); s1[r] = fast_exp2(s1[r] - L1[r]); }
            bf16x8 pb[4]; pack_p(pb, s0, s1);
            pv_tile(o0, o1, buf + 8192, pb, lane);
            wdone = __all(C > SB_DONE);
        }
        if (lane == 0) DONE[((i + 1) & 1) * 8 + wid] = wdone ? 1u : 0u;
    }
    asm volatile("s_waitcnt vmcnt(0) lgkmcnt(0)\n\ts_barrier" ::: "memory");
    store_ot(ring + wid * 4096, o0, o1, O + (size_t)(b * SEQ + qw) * DM + h * 64, DM, lane);
}

__device__ __forceinline__ void qk_tile_c(f32x16& s0, f32x16& s1, const LAS unsigned char* kb, const bf16x8 (&qr)[4], const f32x16& cini, int r32, int hi) {
    s0 = cini; s1 = cini;
#pragma unroll
    for (int d0 = 0; d0 < 4; ++d0) { const LAS unsigned char* p = kb + (2 * d0 + hi) * 1024 + r32 * 16;
        const bf16x8 k0 = *(const LAS bf16x8*)p, k1 = *(const LAS bf16x8*)(p + 512);
        s0 = mfma32(k0, qr[d0], s0); s1 = mfma32(k1, qr[d0], s1); }
}
#define MAX3(a, b, c) __builtin_fmaxf(__builtin_fmaxf((a), (b)), (c))
constexpr float SM_THR = 8.0f;
#define SM_TILE(buf, c0, MASK, lim_, dbase_, first_) do { \
        f32x16 ci_; _Pragma("unroll") for (int r = 0; r < 16; ++r) ci_[r] = (c0); \
        f32x16 s0_, s1_; qk_tile_c(s0_, s1_, (buf), qr, ci_, r32, hi); \
        if ((MASK) == 1) { _Pragma("unroll") for (int r = 0; r < 16; ++r) { s0_[r] = (CK(0, r) <= (lim_)) ? s0_[r] : -1.0e30f; s1_[r] = (CK(1, r) <= (lim_)) ? s1_[r] : -1.0e30f; } } \
        if ((MASK) == 2) { _Pragma("unroll") for (int r = 0; r < 16; ++r) { s0_[r] = ((unsigned)((dbase_) - CK(0, r)) < 512u) ? s0_[r] : -1.0e30f; s1_[r] = ((unsigned)((dbase_) - CK(1, r)) < 512u) ? s1_[r] : -1.0e30f; } } \
        float ma_ = MAX3(s0_[0], s0_[1], s1_[0]), mb_ = MAX3(s0_[2], s0_[3], s1_[1]); ma_ = MAX3(ma_, s1_[2], s1_[3]); \
        _Pragma("unroll") for (int r = 4; r < 16; r += 4) { ma_ = MAX3(ma_, s0_[r], s0_[r + 1]); mb_ = MAX3(mb_, s0_[r + 2], s0_[r + 3]); ma_ = MAX3(ma_, s1_[r], s1_[r + 1]); mb_ = MAX3(mb_, s1_[r + 2], s1_[r + 3]); } \
        const float mx_ = xhalf_max(fmaxf(ma_, mb_)); \
        if (__any(mx_ > SM_THR) || (first_)) { const float dl_ = (first_) ? fmaxf(mx_, -100.f) : fmaxf(mx_, 0.f), al_ = fast_exp2(-dl_); m_run += dl_; l_run *= al_;   \
            _Pragma("unroll") for (int r = 0; r < 16; ++r) { s0_[r] -= dl_; s1_[r] -= dl_; oa0[r] *= al_; oa1[r] *= al_; } } \
        f32x2 ps_ = (f32x2){0.f, 0.f}; \
        _Pragma("unroll") for (int r = 0; r < 16; ++r) { s0_[r] = fast_exp2(s0_[r]); s1_[r] = fast_exp2(s1_[r]); ps_ += (f32x2){s0_[r], s1_[r]}; } \
        l_run += ps_[0] + ps_[1]; \
        bf16x8 pb_[4]; pack_p(pb_, s0_, s1_); pv_tile(oa0, oa1, (buf) + 8192, pb_, lane); } while (0)

__device__ __forceinline__ void nsa_unit(LAS unsigned char* lds, const bf16_t* Q, const unsigned char* NSAI, const bf16_t* KCV, const float* GATE, bf16_t* O, int b, int g, int tb, int wid, int lane) {
    const int r32 = lane & 31, hi = lane >> 5, rh = wid & 3, th = wid >> 2;
    const int tloc = 32 * th + r32, t = 64 * tb + tloc; const size_t row = (size_t)b * SEQ + t;
    bf16x8 qr[4];
    { const bf16_t* Qp = Q + row * DM + 512 + (g * 4 + rh) * 64;
#pragma unroll
      for (int d0 = 0; d0 < 4; ++d0) qr[d0] = *(const bf16x8*)(Qp + d0 * 16 + hi * 8); }
    const float* gp = GATE + row * 32 + g * 12 + rh * 3;
    float gt0 = gp[0], gt1 = gp[1], gt2 = gp[2];
    asm volatile("" : "+v"(qr[0]), "+v"(qr[1]), "+v"(qr[2]), "+v"(qr[3]), "+v"(gt0), "+v"(gt1), "+v"(gt2));
    f32x16 tot0, tot1;
    LAS unsigned char* ring = lds + ATT_RING;
    const unsigned char* ImS = NSAI + (size_t)(((0 * 16 + b) * 2 + g) * 32) * 8192; const unsigned char* ImW = NSAI + (size_t)(((2 * 16 + b) * 2 + g) * 32) * 8192;
    constexpr size_t VOFF = (size_t)16 * 2 * 32 * 8192;
    const int jw0 = tb >= 8 ? tb - 8 : 0, nwin = tb - jw0 + 1, nel = nwin + tb + 1;
#define EL_DMA(e, slotp) do { const unsigned char* ki_ = ((e) < nwin) ? ImW + (size_t)(jw0 + (e)) * 8192 : ImS + (size_t)((e) - nwin) * 8192; kv_dma_img((slotp), ki_, ki_ + VOFF, wid, lane); } while (0)
    {
        const bf16_t* Kc = KCV + (size_t)((b * 2 + g) * 128) * 64; const bf16_t* Vc = Kc + (size_t)4096 * 64;
        kv_dma(ring, Kc, Vc, 64, 0, wid, lane); kv_dma(ring + ATT_SLOT, Kc, Vc, 64, 64, wid, lane);
        EL_DMA(0, ring + 2 * ATT_SLOT); EL_DMA(1, ring + 3 * ATT_SLOT);
        wait_bar(2);
    }
    {
        f32x16 p[4];
        qk_tile(p[0], p[1], ring, qr, r32, hi); qk_tile(p[2], p[3], ring + ATT_SLOT, qr, r32, hi);
        float mx = -1.0e30f; const int tcmp = t - 31 - 64 * hi;
#pragma unroll
        for (int a = 0; a < 4; ++a)
#pragma unroll
            for (int r = 0; r < 16; ++r) { p[a][r] = (16 * CK(a, r) <= tcmp) ? p[a][r] : -1.0e30f; mx = fmaxf(mx, p[a][r]); }
        mx = fmaxf(xhalf_max(mx), -1.0e29f);
        float ls = 0.f;
#pragma unroll
        for (int a = 0; a < 4; ++a)
#pragma unroll
            for (int r = 0; r < 16; ++r) { p[a][r] = fast_exp2(p[a][r] - mx); ls += p[a][r]; }
        ls = xhalf_sum(ls); const float inv = ls > 0.f ? 1.0f / ls : 0.f;
#pragma unroll
        for (int a = 0; a < 4; ++a)
#pragma unroll
            for (int r = 0; r < 16; ++r) p[a][r] *= inv;
        LAS float* impw = (LAS float*)(lds + ATT_IMP) + (rh * 64 + tloc) * 33;
        float carry = 0.f;
#pragma unroll
        for (int a = 0; a < 4; ++a) {
            const float e0 = __shfl_xor(p[a][3], 32), e1 = __shfl_xor(p[a][7], 32), e2 = __shfl_xor(p[a][11], 32), e3 = __shfl_xor(p[a][15], 32);
            const float o0 = (p[a][0] + p[a][1]) + (p[a][2] + p[a][3]), o1 = (p[a][4] + p[a][5]) + (p[a][6] + p[a][7]);
            const float o2 = (p[a][8] + p[a][9]) + (p[a][10] + p[a][11]), o3 = (p[a][12] + p[a][13]) + (p[a][14] + p[a][15]);
            impw[8 * a + 0 + hi] = o0 + (hi ? e0 : carry);
            impw[8 * a + 2 + hi] = o1 + (hi ? e1 : e0);
            impw[8 * a + 4 + hi] = o2 + (hi ? e2 : e1);
            impw[8 * a + 6 + hi] = o3 + (hi ? e3 : e2);
            carry = e3; }
#pragma unroll
        for (int a = 0; a < 4; ++a)
#pragma unroll
            for (int r = 0; r < 16; ++r) p[a][r] *= gt0;
        tot0 = (f32x16){}; tot1 = (f32x16){};
        { bf16x8 pb[4]; pack_p(pb, p[0], p[1]); pv_tile(tot0, tot1, ring + 8192, pb, lane); }
        { bf16x8 pb[4]; pack_p(pb, p[2], p[3]); pv_tile(tot0, tot1, ring + ATT_SLOT + 8192, pb, lane); }
    }
    f32x16 oa0 = (f32x16){}, oa1 = (f32x16){}; float m_run = 0.f, l_run = 0.f; unsigned selmask = 0u;
    for (int i = 0; i < nel; ++i) {
        const int li = (i == 0) ? 1 : ((i + 2 < nel - 1) ? i + 2 : nel - 1);
        wait_bar(li - i);
        if (i == 0) { if (2 < nel) EL_DMA(2, ring); if (3 < nel) EL_DMA(3, ring + ATT_SLOT); }
        else if (i + 3 < nel) EL_DMA(i + 3, ring + ((i + 5) & 3) * ATT_SLOT);
        if (i == 0) {
            const LAS float* imp = (const LAS float*)(lds + ATT_IMP);
            LAS unsigned* SEL = (LAS unsigned*)(lds + ATT_SEL);
#pragma unroll 1
            for (int it = 0; it < 4; ++it) { const int tl = 8 * wid + 2 * it + hi, sb = r32;
                const float v = ((imp[(0 * 64 + tl) * 33 + sb] + imp[(1 * 64 + tl) * 33 + sb]) + imp[(2 * 64 + tl) * 33 + sb]) + imp[(3 * 64 + tl) * 33 + sb];
                const bool valid = sb <= tb, forced = (sb == 0) || (sb == tb) || (sb == tb - 1);
                const float val = valid ? (forced ? 1.0e30f : v) : -1.0e30f;
                int rank = 0;
#pragma unroll 8
                for (int s2 = 0; s2 < 32; ++s2) { const float o = __shfl(val, (lane & 32) | s2); rank += ((o > val) || (o == val && s2 < sb)) ? 1 : 0; }
                const unsigned long long bal = __ballot(rank < 16);
                if (lane == 0) { SEL[8 * wid + 2 * it] = (unsigned)bal; SEL[8 * wid + 2 * it + 1] = (unsigned)(bal >> 32); } }
        }
        if (i == nwin) {
            const float lt = xhalf_sum(l_run); const float sc = (lt > 0.f ? 1.0f / lt : 0.f) * gt2;
#pragma unroll
            for (int r = 0; r < 16; ++r) { tot0[r] += sc * oa0[r]; tot1[r] += sc * oa1[r]; oa0[r] = 0.f; oa1[r] = 0.f; }
            m_run = 0.f; l_run = 0.f;
            selmask = *(const LAS unsigned*)(lds + ATT_SEL + tloc * 4);
        }
        const LAS unsigned char* buf = ring + ((i + 2) & 3) * ATT_SLOT;
        if (i < nwin) { const int j = jw0 + i; const int dbase = 64 * (tb - j) + tloc - 4 * hi;
            if (j == tb || (tb >= 8 && j == jw0)) SM_TILE(buf, -m_run, 2, 0, dbase, i == 0);
            else SM_TILE(buf, -m_run, 0, 0, 0, i == 0);
        } else { const int j = i - nwin; const bool rs = (selmask >> j) & 1u;
            if (j == tb) { const int lim = tloc - 4 * hi; SM_TILE(buf, -m_run, 1, lim, 0, j == 0); }
            else { const float c0 = rs ? -m_run : -1.0e30f; SM_TILE(buf, c0, 0, 0, 0, j == 0); }
        }
    }
    { const float lt = xhalf_sum(l_run); const float sc = (lt > 0.f ? 1.0f / lt : 0.f) * gt1;
#pragma unroll
      for (int r = 0; r < 16; ++r) { tot0[r] += sc * oa0[r]; tot1[r] += sc * oa1[r]; } }
    asm volatile("s_waitcnt vmcnt(0) lgkmcnt(0)\n\ts_barrier" ::: "memory");
    store_ot(ring + wid * 4096, tot0, tot1, O + ((size_t)b * SEQ + 64 * tb + 32 * th) * DM + 512 + (g * 4 + rh) * 64, DM, lane);
#undef EL_DMA
}
#undef SM_TILE
#undef MAX3

#ifndef PHSEL
#define PHSEL 0xffffffffu
#endif
#ifndef ATTREP
#define ATTREP 1
#endif
#ifndef REPMASK
#define REPMASK 0u
#endif
#define PH(n) _Pragma("unroll") for (int rep_ = 0; rep_ < (int)(((PHSEL >> (n)) & 1u) + ((REPMASK >> (n)) & 1u)); ++rep_)
typedef const __attribute__((address_space(4))) Args* KArgP;
__device__ __forceinline__ KArgP opq_kernarg() { unsigned long long p = (unsigned long long)__builtin_amdgcn_kernarg_segment_ptr(); asm volatile("" : "+s"(p)); return (KArgP)p; }
__device__ __forceinline__ Args load_args() { Args r; const __attribute__((address_space(4))) unsigned long long* q = (const __attribute__((address_space(4))) unsigned long long*)opq_kernarg();
#pragma unroll
    for (int i = 0; i < (int)(sizeof(Args) / 8); ++i) ((unsigned long long*)&r)[i] = q[i];
    return r; }
#define KARGS const Args a = load_args(); unsigned char* const ws = a.ws; unsigned* const ctl = (unsigned*)(ws + WS_CTL); \
    const float* const MOD0 = (const float*)(ws + WS_MOD); const float* const MOD1 = MOD0 + 16 * 6144; \
    bf16_t* const R1 = (bf16_t*)(ws + WS_R1); bf16_t* const R2 = (bf16_t*)(ws + WS_R2); bf16_t* const R3 = (bf16_t*)(ws + WS_R3); \
    bf16_t* const KC = (bf16_t*)(ws + R3_KC); float* const GATE = (float*)(ws + R3_GATE); bf16_t* const HID = (bf16_t*)(ws + R3_HID); bf16_t* const KCV = (bf16_t*)(ws + R3_KCV); \
    (void)ctl; (void)MOD0; (void)MOD1; (void)R1; (void)R2; (void)R3; (void)KC; (void)GATE; (void)HID; (void)KCV;
__global__ void __launch_bounds__(512, 2) hybrid_fwd(Args a_unused) {
    extern __shared__ __attribute__((aligned(16))) unsigned char lds_raw[];
    LAS unsigned char* lds = (LAS unsigned char*)lds_raw;
    const int tid0 = threadIdx.x;
    const int G = gridDim.x, bx = blockIdx.x;
    volatile LAS unsigned* MISC = (volatile LAS unsigned*)(lds + MISC_OFF);
    if (tid0 < 32) MISC[tid0] = 0u;
    __syncthreads();
    XcdBarrier bar;
    { KARGS bar = xcd_barrier_post(ctl + CW_BAR, MISC + 8); }
#define GRID_BAR() xcd_barrier(bar)

    PH(0) { KARGS phase_prologue(a, lds, opaque_tid()); }
    GRID_BAR();
    PH(1) { KARGS phase_modulate(a.x, MOD0 + 1024, MOD0, R1, opaque_tid()); }
    GRID_BAR();
    PH(2) { KARGS pg8::Gemm g{R1, (const bf16_t*)(ws + W_MIX), DM, DM, nullptr}; GridOrder S; S.init(MTOK / 256, MIXNP / 256, G, bx);
      EpiMix E{(bf16_t*)(ws + R2_Q), ws + R2_SBK, ws + R2_SBV, ws + R2_NSA, KC, GATE};
      pg8::gemm_phase<EpiMix, GridOrder, true, false>(lds, g, S, E); }
    GRID_BAR();
    PH(3) if (bx < 32) { KARGS
        { pg8::Gemm g{KC, (const bf16_t*)(ws + W_C1), 1024, 2048, nullptr}; CmpOrder S{G, bx};
          EpiPlain<1> E{HID, 256, (const float*)(ws + WS_CBIAS), 256, 1};
          pg8::gemm_phase<EpiPlain<1>, CmpOrder, false, false>(lds, g, S, E); }
        asm volatile("s_waitcnt vmcnt(0)" ::: "memory"); __syncthreads();
        __builtin_amdgcn_fence(__ATOMIC_ACQUIRE, "agent"); asm volatile("s_waitcnt vmcnt(0)" ::: "memory"); __syncthreads();
        { pg8::Gemm g{HID, (const bf16_t*)(ws + W_C2), 256, 256, nullptr}; CmpOrder S{G, bx};
          EpiPlain<0> E{KCV, 64, nullptr, 64, 1};
          pg8::gemm_phase<EpiPlain<0>, CmpOrder, false, false>(lds, g, S, E); }
    }
    PH(4) { KARGS const int tid = opaque_tid(), lane = tid & 63, wid = __builtin_amdgcn_readfirstlane(tid >> 6);
      for (;;) { const int u = wq_next(ctl + CW_WQ, lds, opaque_tid()); if (u >= 1024) break;
        for (int q_ = 0; q_ < ATTREP; ++q_) { sb_unit(lds, (const bf16_t*)(ws + R2_Q), ws + R2_SBK, ws + R2_SBV, R1, (u & 127) >> 3, u & 7, 7 - (u >> 7), wid, lane); __syncthreads(); } } }
    GRID_BAR();
    PH(5) { KARGS const int tid = opaque_tid(), lane = tid & 63, wid = __builtin_amdgcn_readfirstlane(tid >> 6);
      for (;;) { const int u = wq_next(ctl + CW_WQ + 64, lds, opaque_tid()); if (u >= 1024) break;
        for (int q_ = 0; q_ < ATTREP; ++q_) { nsa_unit(lds, (const bf16_t*)(ws + R2_Q), ws + R2_NSA, KCV, GATE, R1, (u & 31) >> 1, u & 1, 31 - (u >> 5), wid, lane); __syncthreads(); } } }
    GRID_BAR();
    PH(6) { KARGS pg8::Gemm g{R1, (const bf16_t*)(ws + W_OUT), DM, DM, nullptr}; GridOrder S; S.init(MTOK / 256, 4, G, bx);
      EpiPlain<0> E{R3, DM, nullptr, DM, 4};
      pg8::gemm_phase<EpiPlain<0>, GridOrder, true, false>(lds, g, S, E); }
    GRID_BAR();
    PH(7) { KARGS phase_ln<true, true, false>(a.x, DN_ALPHA, 1.0f, R3, MOD0 + 2048, a.ln_g, a.ln_b, a.out, R1, MOD0 + 4096, MOD0 + 3072, nullptr, nullptr, nullptr, nullptr, nullptr, opaque_tid()); }
    GRID_BAR();
    PH(8) { KARGS pg8::Gemm g{R1, (const bf16_t*)(ws + W_F13), DM, DM, nullptr}; GridOrder S; S.init(MTOK / 256, 22, G, bx);
      EpiSwiGLU E{R2, DFF, 22};
      pg8::gemm_phase<EpiSwiGLU, GridOrder, true, false>(lds, g, S, E); }
    GRID_BAR();
    PH(9) { KARGS pg8::Gemm g{R2, (const bf16_t*)(ws + W_F2), DFF, DFF, nullptr}; GridOrder S; S.init(MTOK / 256, 4, G, bx);
      EpiPlain<0> E{R3, DM, nullptr, DM, 4};
      pg8::gemm_phase<EpiPlain<0>, GridOrder, true, false>(lds, g, S, E); }
    GRID_BAR();
    PH(10) { KARGS phase_ln<true, true, false>(a.out, DN_ALPHA, 1.0f, R3, MOD0 + 5120, a.ln_g + 1024, a.ln_b + 1024, a.out, R1, MOD1 + 1024, MOD1, nullptr, nullptr, nullptr, nullptr, nullptr, opaque_tid()); }
    GRID_BAR();
    PH(11) { KARGS pg8::Gemm g{R1, (const bf16_t*)(ws + W_CIN), DM, DM, nullptr}; GridOrder S; S.init(MTOK / 256, 12, G, bx);
      EpiConvIn E{R2, R2 + (size_t)MTOK * DM};
      pg8::gemm_phase<EpiConvIn, GridOrder, true, false>(lds, g, S, E); }
    GRID_BAR();
    PH(12) { KARGS phase_conv(R2, R2 + (size_t)MTOK * DM, a.conv_taps, R3, opaque_tid()); }
    GRID_BAR();
    PH(13) { KARGS pg8::Gemm g{R3, (const bf16_t*)(ws + W_COUT), DM, DM, nullptr}; GridOrder S; S.init(MTOK / 256, 4, G, bx);
      EpiPlain<0> E{R1, DM, nullptr, DM, 4};
      pg8::gemm_phase<EpiPlain<0>, GridOrder, true, false>(lds, g, S, E); }
    GRID_BAR();
    PH(14) { KARGS phase_ln<true, true, true>(a.out, DN_ALPHA, DN_ALPHA, R1, MOD1 + 2048, a.ln_g + 2048, a.ln_b + 2048, a.out, R3, MOD1 + 4096, MOD1 + 3072, a.router_w, a.router_b,
                               ctl + CW_ECNT, (int*)(ws + WS_ASG), (float*)(ws + WS_AGATE), opaque_tid()); }
    GRID_BAR();
    PH(15) { KARGS phase_moe_rows(ws, opaque_tid()); }
    GRID_BAR();
#pragma unroll 1
    for (int k = 0; k < 2; ++k) {
        MoeOrder S; S.G = G; S.c = bx; S.tend = (const LAS unsigned*)(lds + MISC_OFF + 64);
        __syncthreads();
        { KARGS if (tid0 < 8) ((LAS unsigned*)(lds + MISC_OFF + 64))[tid0] = xb_ld(ctl + CW_TEND + 8 * k + tid0); }
        __syncthreads();
        const int nt_all = __builtin_amdgcn_readfirstlane((int)S.tend[7]);
        PH(16) { KARGS const int* rowtok = (const int*)(ws + WS_ROWTOK) + k * MOE_ROWS;
          S.NJ = 22; S.ntiles = nt_all; S.nsplit = 0; pg8::Gemm g{R3, (const bf16_t*)(ws + W_E13), DM, DM, rowtok};
          EpiSwiGLU E{(bf16_t*)(ws + WS_R1), DFF, 22};
          pg8::gemm_phase<EpiSwiGLU, MoeOrder, true, true>(lds, g, S, E); }
        GRID_BAR();
        PH(17) { KARGS const int* rowtok = (const int*)(ws + WS_ROWTOK) + k * MOE_ROWS; const float* rowgate = (const float*)(ws + WS_ROWGATE) + k * MOE_ROWS;
          S.NJ = 4; S.ntiles = nt_all; S.nsplit = 0;
          pg8::Gemm g{(const bf16_t*)(ws + WS_R1), (const bf16_t*)(ws + W_E2), DFF, DFF, nullptr};
          EpiMoeDown E{a.out, rowtok, rowgate, MOD1 + 5120}; pg8::gemm_phase<EpiMoeDown, MoeOrder, true, false>(lds, g, S, E); }
        GRID_BAR();
    }
    PH(18) { KARGS phase_ln<false, false, false>(a.out, 1.0f, 1.0f, nullptr, nullptr, a.ln_g + 3072, a.ln_b + 3072, a.out, nullptr, nullptr, nullptr, nullptr, nullptr, nullptr, nullptr, nullptr, opaque_tid()); }
#undef GRID_BAR
}

extern "C" void kernel_launch(void* const* d_in, const int* in_sizes, int n_in, void* d_out, int out_size, void* d_ws, size_t ws_size, hipStream_t stream) {
    static int grid = 0;
    if (grid == 0) {
        if (n_in != 22 || in_sizes[0] != MTOK * DM || out_size != MTOK * DM || ws_size < WS_END) {
            fprintf(stderr, "kernel_launch: unexpected problem (n_in %d, in0 %d, out %d, ws %zu); nothing launched\n", n_in, n_in > 0 ? in_sizes[0] : -1, out_size, ws_size); grid = -1; return; }
        int dev = 0, cus = 0, per_cu = 0;
        if (hipGetDevice(&dev) != hipSuccess || hipDeviceGetAttribute(&cus, hipDeviceAttributeMultiprocessorCount, dev) != hipSuccess) { grid = -1; return; }
        if (hipFuncSetAttribute((const void*)hybrid_fwd, hipFuncAttributeMaxDynamicSharedMemorySize, LDS_BYTES) != hipSuccess) { fprintf(stderr, "kernel_launch: hipFuncSetAttribute failed\n"); grid = -1; return; }
        if (hipOccupancyMaxActiveBlocksPerMultiprocessor(&per_cu, (const void*)hybrid_fwd, 512, LDS_BYTES) != hipSuccess || per_cu < 1)
            fprintf(stderr, "kernel_launch: note: occupancy query reports %d workgroups per CU\n", per_cu);
        (void)hipGetLastError();
        grid = cus;
    }
    if (grid < 0) return;
    if (hipMemsetAsync((char*)d_ws + WS_CTL, 0, CTL_BYTES, stream) != hipSuccess) { fprintf(stderr, "kernel_launch: hipMemsetAsync failed\n"); return; }
    Args a{};
    a.x = (const float*)d_in[0]; a.c = (const float*)d_in[1]; a.ada_w = (const float*)d_in[2]; a.ada_b = (const float*)d_in[3]; a.ln_g = (const float*)d_in[4]; a.ln_b = (const float*)d_in[5];
    a.mix_w_in = (const float*)d_in[6]; a.cmp_pos = (const float*)d_in[7]; a.cmp_w1 = (const float*)d_in[8]; a.cmp_w2 = (const float*)d_in[9]; a.mix_w_out = (const float*)d_in[10];
    a.ffn_w1 = (const float*)d_in[11]; a.ffn_w3 = (const float*)d_in[12]; a.ffn_w2 = (const float*)d_in[13]; a.conv_w_in = (const float*)d_in[14]; a.conv_taps = (const float*)d_in[15];
    a.conv_w_out = (const float*)d_in[16]; a.router_w = (const float*)d_in[17]; a.router_b = (const float*)d_in[18]; a.exp_w1 = (const float*)d_in[19]; a.exp_w3 = (const float*)d_in[20];
    a.exp_w2 = (const float*)d_in[21];
    a.out = (float*)d_out; a.ws = (unsigned char*)d_ws;
    hipLaunchKernelGGL(hybrid_fwd, dim3(grid), dim3(512), LDS_BYTES, stream, a);
    const hipError_t le = hipPeekAtLastError();
    if (le != hipSuccess) fprintf(stderr, "kernel_launch: launch failed: %s\n", hipGetErrorName(le));
}
```

```cpp
#include <hip/hip_runtime.h>
#include <cstdio>
#include <cstdint>

#define LAS __attribute__((address_space(3)))
#define GAS __attribute__((address_space(1)))
typedef unsigned short bf16_t;
typedef short bf16x8 __attribute__((ext_vector_type(8)));
typedef short s16x4 __attribute__((ext_vector_type(4)));
typedef float f32x4 __attribute__((ext_vector_type(4)));
typedef float f32x2 __attribute__((ext_vector_type(2)));
typedef float f32x16 __attribute__((ext_vector_type(16)));
typedef unsigned u32x4 __attribute__((ext_vector_type(4)));
typedef unsigned u32x2 __attribute__((ext_vector_type(2)));

constexpr int BATCH = 16, SEQ = 2048, DM = 1024, MTOK = BATCH * SEQ;
constexpr int NPROJ = 2816;
constexpr int MIXN = 2840, MIXNP = 3072;
constexpr int DFF = 2816, NEXP = 8;
constexpr int MOE_ROWS = 34816;
constexpr float LN_EPS = 1e-5f;
constexpr float DN_ALPHA = 1.4142135623730951f;
constexpr float LOG2E = 1.4426950408889634f;
constexpr float QSCALE = 0.125f * LOG2E;

constexpr size_t MiB = 1u << 20;
constexpr size_t WS_CTL = 0, CTL_BYTES = 1 * MiB;
constexpr size_t WS_SMALL = 1 * MiB;
constexpr size_t WS_MOD = WS_SMALL;
constexpr size_t WS_CBIAS = WS_MOD + 786432;
constexpr size_t WS_ASG = WS_CBIAS + 4096;
constexpr size_t WS_AGATE = WS_ASG + 2 * MTOK * 4;
constexpr size_t WS_ROWTOK = WS_AGATE + 2 * MTOK * 4;
constexpr size_t WS_ROWGATE = WS_ROWTOK + 2 * MOE_ROWS * 4;
constexpr size_t WS_SMALL_END = WS_ROWGATE + 2 * MOE_ROWS * 4;
static_assert(WS_SMALL_END <= 8 * MiB, "small tables");
constexpr size_t WS_W = 8 * MiB;
constexpr size_t W_MIX = WS_W;
constexpr size_t W_OUT = W_MIX + (size_t)MIXNP * DM * 2;
constexpr size_t W_F13 = W_OUT + (size_t)DM * DM * 2;
constexpr size_t W_F2 = W_F13 + (size_t)2 * DFF * DM * 2;
constexpr size_t W_CIN = W_F2 + (size_t)DM * DFF * 2;
constexpr size_t W_COUT = W_CIN + (size_t)3 * DM * DM * 2;
constexpr size_t W_E13 = W_COUT + (size_t)DM * DM * 2;
constexpr size_t W_E2 = W_E13 + (size_t)NEXP * 2 * DFF * DM * 2;
constexpr size_t W_C1 = W_E2 + (size_t)NEXP * DM * DFF * 2;
constexpr size_t W_C2 = W_C1 + (size_t)2 * 256 * 2048 * 2;
constexpr size_t WS_W_END = W_C2 + (size_t)2 * 256 * 256 * 2;
constexpr size_t WS_R1 = 176 * MiB;
constexpr size_t WS_R2 = 240 * MiB;
constexpr size_t WS_R3 = 416 * MiB;
constexpr size_t WS_END = 480 * MiB;
static_assert(WS_W_END <= WS_R1, "weights fit");
static_assert((size_t)MOE_ROWS * DFF * 2 <= WS_R3 - WS_R1, "MoE activation chunk fits R1+R2");
constexpr size_t R2_Q = WS_R2;
constexpr size_t R2_SBK = WS_R2 + 64 * MiB;
constexpr size_t R2_SBV = WS_R2 + 96 * MiB;
constexpr size_t R2_NSA = WS_R2 + 128 * MiB;
constexpr size_t R3_KC = WS_R3;
constexpr size_t R3_KCPAD = R3_KC + 16 * MiB;
constexpr size_t R3_GATE = R3_KC + 17 * MiB;
constexpr size_t R3_HID = R3_KC + 21 * MiB;
constexpr size_t R3_KCV = R3_KC + 25 * MiB;

constexpr int CW_BAR = 4096;
constexpr int CW_WQ = 8192;
constexpr int CW_ECNT = 9216;
constexpr int CW_TEND = 12288;
constexpr int CW_XRANK = 13312;

constexpr int LDS_BYTES = 147456;
constexpr int MISC_OFF = 131072 + 320;

__device__ __forceinline__ unsigned cvt_pk_bf16(float lo, float hi) { unsigned r; asm volatile("v_cvt_pk_bf16_f32 %0, %1, %2" : "=v"(r) : "v"(lo), "v"(hi)); return r; }
__device__ __forceinline__ float bf2f(bf16_t v) { return __uint_as_float((unsigned)v << 16); }
__device__ __forceinline__ float bflo(unsigned w) { return __uint_as_float(w << 16); }
__device__ __forceinline__ float bfhi(unsigned w) { return __uint_as_float(w & 0xffff0000u); }
__device__ __forceinline__ float fast_exp2(float x) { return __builtin_amdgcn_exp2f(x); }
__device__ __forceinline__ float fast_log2(float x) { return __builtin_amdgcn_logf(x); }
__device__ __forceinline__ float fast_rcp(float x) { return __builtin_amdgcn_rcpf(x); }
__device__ __forceinline__ float silu_f(float a) { return a * fast_rcp(1.0f + fast_exp2(-a * LOG2E)); }
__device__ __forceinline__ float sigmoid_f(float a) { return fast_rcp(1.0f + fast_exp2(-a * LOG2E)); }
__device__ __forceinline__ float wave_sum(float v) {
#pragma unroll
    for (int o = 1; o < 64; o <<= 1) v += __shfl_xor(v, o);
    return v;
}

__device__ __forceinline__ int opaque_tid() { int t = threadIdx.x; asm volatile("" : "+v"(t)); return t; }

namespace pg8 {
constexpr int BM = 256, BK = 64, HALF = 128, HTB = HALF * BK * 2, STAGE_BYTES = 8 * HTB;
__host__ __device__ __forceinline__ int lds_byte(int r, int c) { const int st = (r >> 4) * 2 + (c >> 5), rr = r & 15, cc = c & 31, ob = rr * 64 + cc * 2; return st * 1024 + (ob ^ (((ob >> 9) & 1) << 5)); }
__host__ __device__ __forceinline__ void stage_rc(int b, int& R, int& C) { const int st = b / 1024, sb = b % 1024, swz = sb ^ (((sb >> 9) & 1) << 5); R = (st >> 1) * 16 + swz / 64; C = (st & 1) * 32 + (swz % 64) / 2; }
__host__ __device__ __forceinline__ int perm32(int rho) { const int n = rho >> 4, i = rho & 15; return 8 * (i >> 2) + 4 * n + (i & 3); }

struct Unit { int pm, pn; };
struct Gemm { const bf16_t* A; const bf16_t* Bt; int lda; int K; const int* rowidx; };

template <class Epi, class Sched, bool ALIGN_EPI, bool GATHER>
__device__ __forceinline__ void gemm_phase(LAS unsigned char* lds, const Gemm g, const Sched& S, const Epi& E) {
    const int tid = opaque_tid(), wid = __builtin_amdgcn_readfirstlane(tid >> 6), lane = tid & 63, wr = wid >> 2, wc = wid & 3, fr = lane & 15, fq = lane >> 4;
    const int K = g.K, nt = K / BK, lda = g.lda;
    unsigned vA[2][2], vAn[2][2], vB[2]; int rA[2], cA2[2];
#pragma unroll
    for (int i = 0; i < 2; ++i) { int R, C; stage_rc(tid * 16 + i * 8192, R, C); const int Rb = Epi::PERM ? ((R & ~31) + perm32(R & 31)) : R;
        rA[i] = R; cA2[i] = C * 2;
        vA[0][i] = (unsigned)(R * lda + C) * 2u; vA[1][i] = (unsigned)((R + HALF) * lda + C) * 2u; vB[i] = (unsigned)(Rb * K + C) * 2u;
        vAn[0][i] = vA[0][i]; vAn[1][i] = vA[1][i]; }
    const size_t kstep = (size_t)(BK * 2);
    const size_t hstepB = (size_t)HALF * K * 2;
    const size_t tstepB = 2 * hstepB;
    const size_t tstepA = (size_t)BM * lda * 2;
    const unsigned ldsw = (unsigned)wid * 1024u;
    const int aoff = lds_byte(wr * 64 + fr, fq * 8), boff = lds_byte(wc * 32 + fr, fq * 8);
#define PG8_SA(b, h) (((b) * 2 + (h)) * HTB)
#define PG8_SB(b, h) ((4 + (b) * 2 + (h)) * HTB)
#define PG8_STAGE2(bufoff, gbase, o0, o1) do { \
        __builtin_amdgcn_global_load_lds((const unsigned*)((const char*)(gbase) + (o0)), (LAS unsigned*)(lds + (bufoff) + ldsw), 16, 0, 0); \
        __builtin_amdgcn_global_load_lds((const unsigned*)((const char*)(gbase) + (o1)), (LAS unsigned*)(lds + (bufoff) + ldsw + 8192), 16, 0, 0); } while (0)
#define PG8_STB(bufoff, gbase) PG8_STAGE2(bufoff, gbase, vB[0], vB[1])
#define PG8_STA(bufoff, gbase, h) PG8_STAGE2(bufoff, gbase, vA[h][0], vA[h][1])
#define PG8_LDA(dst, b, h) do { _Pragma("unroll") for (int m = 0; m < 4; ++m) _Pragma("unroll") for (int k = 0; k < 2; ++k) dst[m][k] = *(const LAS bf16x8*)(lds + PG8_SA(b, h) + aoff + m * 2048 + k * 1024); } while (0)
#define PG8_LDB(dst, b, h) do { _Pragma("unroll") for (int n = 0; n < 2; ++n) _Pragma("unroll") for (int k = 0; k < 2; ++k) dst[n][k] = *(const LAS bf16x8*)(lds + PG8_SB(b, h) + boff + n * 2048 + k * 1024); } while (0)
#define PG8_MMA(ai, bj, At, Bt) do { __builtin_amdgcn_s_setprio(1); _Pragma("unroll") for (int m = 0; m < 4; ++m) _Pragma("unroll") for (int n = 0; n < 2; ++n) _Pragma("unroll") for (int k = 0; k < 2; ++k) \
        acc[ai][bj][m][n] = __builtin_amdgcn_mfma_f32_16x16x32_bf16(Bt[n][k], At[m][k], acc[ai][bj][m][n], 0, 0, 0); __builtin_amdgcn_s_setprio(0); } while (0)
#define PG8_WAIT_V(n) asm volatile("s_waitcnt vmcnt(" #n ")" ::: "memory")
#define PG8_WAIT_L(n) asm volatile("s_waitcnt lgkmcnt(" #n ")" ::: "memory")
#define PG8_BAR __builtin_amdgcn_s_barrier()
#define PG8_SCHED __builtin_amdgcn_sched_barrier(0)
#define PG8_GIDX(dst, u) do { if constexpr (GATHER) { _Pragma("unroll") for (int h = 0; h < 2; ++h) _Pragma("unroll") for (int i = 0; i < 2; ++i) { \
        int tk = g.rowidx[(u).pm * BM + h * HALF + rA[i]]; tk = tk < 0 ? 0 : tk; dst[h][i] = (unsigned)tk * (unsigned)(lda * 2) + (unsigned)cA2[i]; } } } while (0)
    Unit cur, nxt; int ui = 0;
    if (!S.next(0, cur)) return;
    f32x4 acc[2][2][4][2];
#pragma unroll
    for (int a = 0; a < 2; ++a)
#pragma unroll
        for (int b = 0; b < 2; ++b)
#pragma unroll
            for (int m = 0; m < 4; ++m)
#pragma unroll
                for (int n = 0; n < 2; ++n) acc[a][b][m][n] = (f32x4){0.f, 0.f, 0.f, 0.f};
    bf16x8 At[4][2], B0[2][2], B1[2][2];
    const char* cA = GATHER ? (const char*)g.A : (const char*)g.A + (size_t)cur.pm * tstepA; const char* cB = (const char*)g.Bt + (size_t)cur.pn * tstepB;
    PG8_GIDX(vA, cur);
    PG8_STB(PG8_SB(0, 0), cB); PG8_STB(PG8_SB(0, 1), cB + hstepB); PG8_STA(PG8_SA(0, 0), cA, 0); PG8_STA(PG8_SA(0, 1), cA, 1);
    if (wr == 1) PG8_BAR;
    PG8_WAIT_V(2); PG8_BAR;
    PG8_STB(PG8_SB(1, 0), cB + kstep); PG8_STA(PG8_SA(1, 0), cA + kstep, 0); PG8_STB(PG8_SB(1, 1), cB + hstepB + kstep);
    PG8_WAIT_V(6); PG8_BAR;
    for (;;) {
        const bool has_next = S.next(ui + 1, nxt);
        const char* nA = GATHER ? cA : (has_next ? (const char*)g.A + (size_t)nxt.pm * tstepA : cA); const char* nB = has_next ? (const char*)g.Bt + (size_t)nxt.pn * tstepB : cB;
        if constexpr (GATHER) { if (has_next) { PG8_GIDX(vAn, nxt); } else {
#pragma unroll
            for (int h = 0; h < 2; ++h)
#pragma unroll
                for (int i = 0; i < 2; ++i) vAn[h][i] = vA[h][i]; } }
        for (int t = 0; t < nt; t += 2) {
            const bool last = (t == nt - 2);
            const char* a1 = cA + (size_t)(t + 1) * kstep;
            const char* a2 = last ? nA : cA + (size_t)(t + 2) * kstep; const char* b2 = last ? nB : cB + (size_t)(t + 2) * kstep;
            const char* a3 = a2 + kstep; const char* b3 = b2 + kstep;
            PG8_LDB(B0, 0, 0); PG8_LDB(B1, 0, 1); PG8_SCHED; PG8_LDA(At, 0, 0); PG8_STA(PG8_SA(1, 1), a1, 1);
            if constexpr (GATHER) { if (last) {
#pragma unroll
                for (int h = 0; h < 2; ++h)
#pragma unroll
                    for (int i = 0; i < 2; ++i) vA[h][i] = vAn[h][i]; } }
            PG8_WAIT_V(8); PG8_WAIT_L(0); PG8_BAR; PG8_MMA(0, 0, At, B0); PG8_MMA(0, 1, At, B1); PG8_BAR; PG8_SCHED;
            PG8_LDA(At, 0, 1); PG8_STB(PG8_SB(0, 0), b2); PG8_STB(PG8_SB(0, 1), b2 + hstepB); PG8_STA(PG8_SA(0, 0), a2, 0);
            PG8_WAIT_V(8); PG8_WAIT_L(0); PG8_BAR; PG8_MMA(1, 0, At, B0); PG8_MMA(1, 1, At, B1); PG8_BAR; PG8_SCHED;
            PG8_LDB(B0, 1, 0); PG8_LDB(B1, 1, 1); PG8_SCHED; PG8_LDA(At, 1, 0); PG8_STA(PG8_SA(0, 1), a2, 1);
            PG8_WAIT_V(8); PG8_WAIT_L(0); PG8_BAR; PG8_MMA(0, 0, At, B0); PG8_MMA(0, 1, At, B1); PG8_BAR; PG8_SCHED;
            PG8_LDA(At, 1, 1); PG8_STB(PG8_SB(1, 0), b3); PG8_STB(PG8_SB(1, 1), b3 + hstepB); PG8_STA(PG8_SA(1, 0), a3, 0);
            PG8_WAIT_V(8); PG8_WAIT_L(0); PG8_BAR; PG8_MMA(1, 0, At, B0); PG8_MMA(1, 1, At, B1); PG8_BAR; PG8_SCHED;
        }
        if constexpr (ALIGN_EPI) { if (wr == 0) PG8_BAR; }
        E(acc, cur, wr, wc, fr, fq);
        if (!has_next) break;
#pragma unroll
        for (int a = 0; a < 2; ++a)
#pragma unroll
            for (int b = 0; b < 2; ++b)
#pragma unroll
                for (int m = 0; m < 4; ++m)
#pragma unroll
                    for (int n = 0; n < 2; ++n) acc[a][b][m][n] = (f32x4){0.f, 0.f, 0.f, 0.f};
        cur = nxt; cA = nA; cB = nB; ++ui;
        if constexpr (ALIGN_EPI) { if (wr == 1) PG8_BAR; }
    }
    PG8_WAIT_V(0);
    if constexpr (!ALIGN_EPI) { if (wr == 0) PG8_BAR; }
    PG8_BAR;
#undef PG8_SA
#undef PG8_SB
#undef PG8_STAGE2
#undef PG8_STB
#undef PG8_STA
#undef PG8_LDA
#undef PG8_LDB
#undef PG8_MMA
#undef PG8_WAIT_V
#undef PG8_WAIT_L
#undef PG8_BAR
#undef PG8_SCHED
#undef PG8_GIDX
}
}

#define XB_TMO      128
#define XB_XCNT(j)  (256  + 64 * (j))
#define XB_XSUB(j)  (1280 + 64 * (j))
#define XB_XGEN(j)  (2304 + 64 * (j))
#define XB_TOP      3328
#define XB_TOPGEN   3392
#define XCD_BAR_WORDS 3456
#define XB_SPIN_CAP (1u << 18)
__device__ __forceinline__ unsigned xb_ld(unsigned* p)              { return __hip_atomic_load(p, __ATOMIC_RELAXED, __HIP_MEMORY_SCOPE_AGENT); }
__device__ __forceinline__ unsigned xb_add(unsigned* p, unsigned v) { return __hip_atomic_fetch_add(p, v, __ATOMIC_RELAXED, __HIP_MEMORY_SCOPE_AGENT); }
__device__ __forceinline__ unsigned xb_xcc_id() { return (unsigned)__builtin_amdgcn_s_getreg((3 << 11) | 20) & 0xFu; }
#define XB_SPIN(cond, bar) do { unsigned _sp = 0; while (cond) { __builtin_amdgcn_s_sleep(1); \
    if ((++_sp & 255u) == 0u) { if (xb_ld(&(bar)[XB_TMO])) break; if (_sp > XB_SPIN_CAP) { atomicAdd(&(bar)[XB_TMO], 1u); break; } } } } while (0)
struct XcdBarrier { unsigned* bar; unsigned x; volatile LAS unsigned* st; };
__device__ __forceinline__ XcdBarrier xcd_barrier_post(unsigned* bar, volatile LAS unsigned* st) {
    XcdBarrier b; b.bar = bar; b.x = xb_xcc_id(); b.st = st;
    if (threadIdx.x == 0) (void)xb_add(&bar[XB_XCNT(b.x)], 1u);
    return b;
}
__device__ __forceinline__ void xcd_barrier_complete(unsigned* bar, unsigned x, unsigned& nloc, unsigned& nx) {
    const unsigned G = gridDim.x * gridDim.y * gridDim.z;
    unsigned sum, cnt, mine, sp = 0u;
    for (;;) {
        sum = 0u; cnt = 0u; mine = 0u;
#pragma unroll
        for (unsigned j = 0; j < 16; ++j) { const unsigned c = xb_ld(&bar[XB_XCNT(j)]); sum += c; cnt += (c > 0u) ? 1u : 0u; mine = (j == x) ? c : mine; }
        if (sum == G) break;
        __builtin_amdgcn_s_sleep(1);
        if ((++sp & 255u) == 0u) { if (xb_ld(&bar[XB_TMO])) break; if (sp > XB_SPIN_CAP) { atomicAdd(&bar[XB_TMO], 1u); break; } }
    }
    nloc = mine > 0u ? mine : 1u; nx = cnt > 0u ? cnt : 1u;
}
__device__ __forceinline__ void xcd_barrier(const XcdBarrier& b) {
    asm volatile("s_waitcnt vmcnt(0)" ::: "memory");
    __syncthreads();
    if (threadIdx.x == 0) {
        unsigned* bar = b.bar;
        __builtin_amdgcn_s_waitcnt(0);
        unsigned nloc = b.st[0], nx = b.st[1];
        if (nloc == 0u) { xcd_barrier_complete(bar, b.x, nloc, nx); b.st[0] = nloc; b.st[1] = nx; }
        const unsigned old = xb_add(&bar[XB_XSUB(b.x)], 1u);
        const unsigned gen = old / nloc;
        if (old + 1u == (gen + 1u) * nloc) {
            __builtin_amdgcn_fence(__ATOMIC_RELEASE, "agent");
            asm volatile("s_waitcnt vmcnt(0)" ::: "memory");
            const unsigned og = xb_add(&bar[XB_TOP], 1u);
            const unsigned tg = og / nx;
            if (og + 1u == (tg + 1u) * nx) xb_add(&bar[XB_TOPGEN], 1u);
            else XB_SPIN(xb_ld(&bar[XB_TOPGEN]) == tg, bar);
            __builtin_amdgcn_fence(__ATOMIC_ACQUIRE, "agent");
            xb_add(&bar[XB_XGEN(b.x)], 1u);
            asm volatile("s_waitcnt vmcnt(0)" ::: "memory");
        } else {
            XB_SPIN(xb_ld(&bar[XB_XGEN(b.x)]) == gen, bar);
            __builtin_amdgcn_fence(__ATOMIC_ACQUIRE, "agent");
            asm volatile("s_waitcnt vmcnt(0)" ::: "memory");
        }
    }
    __syncthreads();
}

struct XcdPlace { int base, nloc, r, G; };
struct GridOrder {
    int nM, nN, start, end, nloc, r;
    __device__ __forceinline__ void init(int nM_, int nN_, const XcdPlace& P) { nM = nM_; nN = nN_; const long nwg = (long)nM_ * nN_;
        start = (int)(nwg * P.base / P.G); end = (int)(nwg * (P.base + P.nloc) / P.G); nloc = P.nloc; r = P.r; }
    __device__ __forceinline__ bool next(int i, pg8::Unit& u) const {
        const int L = start + i * nloc + r; if (L >= end) return false;
        const int nig = 8 * nN, gid = L / nig, fm = gid * 8, gsz = (nM - fm) < 8 ? (nM - fm) : 8, w = L % nig;
        u.pm = fm + (w % gsz); u.pn = w / gsz; return true;
    }
};
struct CmpOrder {
    int G, c;
    __device__ __forceinline__ bool next(int i, pg8::Unit& u) const { const int L = i * G + c; if (L >= 32) return false; u.pm = L; u.pn = L >> 4; return true; }
};
struct MoeOrder {
    int base, nloc, r, G, NJ, ntiles; const LAS unsigned* tend;
    __device__ __forceinline__ bool next(int i, pg8::Unit& u) const {
        const long nwg = (long)ntiles * NJ; const int start = (int)(nwg * base / G), end = (int)(nwg * (base + nloc) / G);
        const int L = start + i * nloc + r; if (L >= end) return false;
        const int nig = 8 * NJ, gid = L / nig, fm = gid * 8, gsz = (ntiles - fm) < 8 ? (ntiles - fm) : 8, w = L % nig;
        const int rt = fm + (w % gsz), j = w / gsz; int e = 0;
#pragma unroll
        for (int q = 0; q < 7; ++q) e += (rt >= (int)tend[q]) ? 1 : 0;
        u.pm = rt; u.pn = __builtin_amdgcn_readfirstlane(e) * NJ + j; return true;
    }
};

typedef const f32x4 (&AccRef)[2][2][4][2];
__device__ __forceinline__ u32x4 pack8(f32x4 a, f32x4 b) { u32x4 w; w.x = cvt_pk_bf16(a[0], a[1]); w.y = cvt_pk_bf16(a[2], a[3]); w.z = cvt_pk_bf16(b[0], b[1]); w.w = cvt_pk_bf16(b[2], b[3]); return w; }

template <int ACT> struct EpiPlain {
    static constexpr bool PERM = true;
    bf16_t* O; int ldc; const float* bias; int ncols_valid; int pn_mod;
    __device__ __forceinline__ void operator()(AccRef acc, const pg8::Unit& u, int wr, int wc, int fr, int fq) const {
        const int row0 = u.pm * 256 + wr * 64 + fr; const int colt = (u.pn % pn_mod) * 256;
#pragma unroll
        for (int bj = 0; bj < 2; ++bj) { const int col = colt + bj * 128 + wc * 32 + 8 * fq; if (col >= ncols_valid) continue;
            f32x4 b0 = (f32x4){0.f, 0.f, 0.f, 0.f}, b1 = b0;
            if (ACT == 1) { const float* bp = bias + u.pn * 256 + bj * 128 + wc * 32 + 8 * fq; b0 = *(const f32x4*)bp; b1 = *(const f32x4*)(bp + 4); }
#pragma unroll
            for (int ai = 0; ai < 2; ++ai)
#pragma unroll
                for (int m = 0; m < 4; ++m) { f32x4 v0 = acc[ai][bj][m][0], v1 = acc[ai][bj][m][1];
                    if (ACT == 1) { v0 += b0; v1 += b1;
#pragma unroll
                        for (int e = 0; e < 4; ++e) { v0[e] = silu_f(v0[e]); v1[e] = silu_f(v1[e]); } }
                    *(u32x4*)(O + (size_t)(row0 + ai * 128 + m * 16) * ldc + col) = pack8(v0, v1); } }
    }
};
struct EpiMix {
    static constexpr bool PERM = true;
    bf16_t* Q; unsigned char* SBK; unsigned char* SBV; unsigned char* NSAI; bf16_t* KC; float* GATE;
    __device__ __forceinline__ void operator()(AccRef acc, const pg8::Unit& u, int wr, int wc, int fr, int fq) const {
        const int row = u.pm * 256 + wr * 64 + fr; const int pn = u.pn;
        const int b = row >> 11, t = row & 2047, tile = t >> 6, key = t & 63;
        const float sc = (pn < 2 || pn == 6 || pn == 7) ? QSCALE : 1.0f;
#pragma unroll
        for (int bj = 0; bj < 2; ++bj) { const int cc = bj * 128 + wc * 32 + 8 * fq;
            unsigned char* base; int sm, sa = 16384; bool gate = false, skip = false;
            if (pn == 11) { gate = true; skip = cc >= 24; base = (unsigned char*)(GATE + (size_t)row * 32 + cc); sm = 2048; }
            else if (pn == 8) { const int which = cc >> 7, g = (cc >> 6) & 1, d = cc & 63; base = (unsigned char*)(KC + ((((size_t)(which * 16 + b) * 2 + g) * 2048 + t) * 64 + d)); sm = 2048; }
            else if (pn < 2 || pn == 6 || pn == 7) { const int col = (pn < 2 ? pn * 256 : 512 + (pn - 6) * 256) + cc; base = (unsigned char*)(Q + (size_t)row * DM + col); sm = 32768; sa = 262144; }
            else if (pn < 6) { const int ci = (pn & 1) * 256 + cc, h = ci >> 6, d0 = ci & 63; const size_t img = ((size_t)((b * 8 + h) * 32 + tile)) * 8192;
                if (pn < 4) { base = SBK + img + (d0 >> 3) * 1024 + key * 16; sm = 256; } else { base = SBV + img + (d0 >> 5) * 4096 + key * 64 + (d0 & 31) * 2; sm = 1024; } }
            else { const int isv = cc >> 7, g = (cc >> 6) & 1, d0 = cc & 63, wimg = (pn - 9) * 2 + isv; const size_t img = ((size_t)(((wimg * 16 + b) * 2 + g) * 32 + tile)) * 8192;
                if (!isv) { base = NSAI + img + (d0 >> 3) * 1024 + key * 16; sm = 256; } else { base = NSAI + img + (d0 >> 5) * 4096 + key * 64 + (d0 & 31) * 2; sm = 1024; } }
            if (skip) continue;
#pragma unroll
            for (int ai = 0; ai < 2; ++ai)
#pragma unroll
                for (int m = 0; m < 4; ++m) { f32x4 v0 = acc[ai][bj][m][0] * sc, v1 = acc[ai][bj][m][1] * sc; unsigned char* dp = base + m * sm + ai * sa;
                    if (gate) {
#pragma unroll
                        for (int e = 0; e < 4; ++e) { v0[e] = sigmoid_f(v0[e]); v1[e] = sigmoid_f(v1[e]); }
                        *(f32x4*)dp = v0; *(f32x4*)(dp + 16) = v1; }
                    else *(u32x4*)dp = pack8(v0, v1); } }
    }
};
struct EpiSwiGLU {
    static constexpr bool PERM = true;
    bf16_t* O; int ldc; int NJ;
    __device__ __forceinline__ void operator()(AccRef acc, const pg8::Unit& u, int wr, int wc, int fr, int fq) const {
        const int row0 = u.pm * 256 + wr * 64 + fr; const int col = (u.pn % NJ) * 128 + wc * 32 + 8 * fq;
#pragma unroll
        for (int ai = 0; ai < 2; ++ai)
#pragma unroll
            for (int m = 0; m < 4; ++m) { f32x4 v0, v1;
#pragma unroll
                for (int e = 0; e < 4; ++e) { v0[e] = silu_f(acc[ai][0][m][0][e]) * acc[ai][1][m][0][e]; v1[e] = silu_f(acc[ai][0][m][1][e]) * acc[ai][1][m][1][e]; }
                *(u32x4*)(O + (size_t)(row0 + ai * 128 + m * 16) * ldc + col) = pack8(v0, v1); }
    }
};
struct EpiConvIn {
    static constexpr bool PERM = true;
    bf16_t* Z; bf16_t* GB;
    __device__ __forceinline__ void operator()(AccRef acc, const pg8::Unit& u, int wr, int wc, int fr, int fq) const {
        const int row0 = u.pm * 256 + wr * 64 + fr;
        if (u.pn < 8) { const int col = u.pn * 128 + wc * 32 + 8 * fq;
#pragma unroll
            for (int ai = 0; ai < 2; ++ai)
#pragma unroll
                for (int m = 0; m < 4; ++m) *(u32x4*)(Z + (size_t)(row0 + ai * 128 + m * 16) * DM + col) = pack8(acc[ai][0][m][0] * acc[ai][1][m][0], acc[ai][0][m][1] * acc[ai][1][m][1]);
        } else {
#pragma unroll
            for (int bj = 0; bj < 2; ++bj) { const int col = (u.pn - 8) * 256 + bj * 128 + wc * 32 + 8 * fq;
#pragma unroll
                for (int ai = 0; ai < 2; ++ai)
#pragma unroll
                    for (int m = 0; m < 4; ++m) *(u32x4*)(GB + (size_t)(row0 + ai * 128 + m * 16) * DM + col) = pack8(acc[ai][bj][m][0], acc[ai][bj][m][1]); }
        }
    }
};
struct EpiMoeDown {
    static constexpr bool PERM = false;
    float* out; const int* rowtok; const float* rowgate; const float* g2; float first_scale; float amul;
    __device__ __forceinline__ void operator()(AccRef acc, const pg8::Unit& u, int wr, int wc, int fr, int fq) const {
        const int row0 = u.pm * 256 + wr * 64 + fr; const int colt = (u.pn & 3) * 256 + wc * 32 + 4 * fq;
#pragma unroll
        for (int ai = 0; ai < 2; ++ai)
#pragma unroll
            for (int m = 0; m < 4; ++m) { const int row = row0 + ai * 128 + m * 16; const int tok = rowtok[row]; if (tok < 0) continue;
                const float gt = rowgate[row]; const float* gp = g2 + (size_t)(tok >> 11) * 6144; float* op = out + (size_t)tok * DM;
#pragma unroll
                for (int bj = 0; bj < 2; ++bj)
#pragma unroll
                    for (int n = 0; n < 2; ++n) { const int col = colt + bj * 128 + n * 16; const f32x4 gg = *(const f32x4*)(gp + col); f32x4 o = *(f32x4*)(op + col);
                        o = o * first_scale;
                        o += (gg + 1.0f) * (gt * amul) * acc[ai][bj][m][n]; *(f32x4*)(op + col) = o; } }
    }
};

struct Args {
    const float *x, *c, *ada_w, *ada_b, *ln_g, *ln_b, *mix_w_in, *cmp_pos, *cmp_w1, *cmp_w2, *mix_w_out, *ffn_w1, *ffn_w3, *ffn_w2,
                *conv_w_in, *conv_taps, *conv_w_out, *router_w, *router_b, *exp_w1, *exp_w3, *exp_w2;
    float* out; unsigned char* ws;
};

__device__ __forceinline__ void transpose_item(const float* W, int N, int k0, int n0, bf16_t* WT, int dK, int drow0, LAS float* scr, int lane) {
    const int n = n0 + (lane & 31); const bool ok = n < N;
    float tv[32];
#pragma unroll
    for (int i = 0; i < 32; ++i) { const int kk = 2 * i + (lane >> 5); tv[i] = ok ? W[(size_t)(k0 + kk) * N + n] : 0.f; }
#pragma unroll
    for (int i = 0; i < 32; ++i) { const int kk = 2 * i + (lane >> 5); scr[kk * 33 + (lane & 31)] = tv[i]; }
    asm volatile("s_waitcnt lgkmcnt(0)" ::: "memory");
    const int c = lane & 7;
#pragma unroll
    for (int j = 0; j < 4; ++j) { const int nn = (lane >> 3) + 8 * j; const LAS float* s = scr + (8 * c) * 33 + nn;
        u32x4 o; o.x = cvt_pk_bf16(s[0 * 33], s[1 * 33]); o.y = cvt_pk_bf16(s[2 * 33], s[3 * 33]); o.z = cvt_pk_bf16(s[4 * 33], s[5 * 33]); o.w = cvt_pk_bf16(s[6 * 33], s[7 * 33]);
        *(u32x4*)(WT + (size_t)(drow0 + nn) * dK + k0 + 8 * c) = o; }
    asm volatile("s_waitcnt lgkmcnt(0)" ::: "memory");
}
__device__ __forceinline__ int il1(int n) { return (n >> 7) * 256 + (n & 127); }
__device__ __forceinline__ void weight_item(const Args& a, int it, LAS float* scr, int lane) {
    unsigned char* ws = a.ws;
#define WITEM(cnt, SRC, KK, NN, NBLK, DST, MODE, ROFF) if (it < (cnt)) { const int bi_ = it >> 3, kb = bi_ % ((KK) / 64), nb = (bi_ / ((KK) / 64)) * 8 + (it & 7), n0 = nb * 32; int dr; \
        if ((MODE) == 0) dr = n0; else if ((MODE) == 1) dr = il1(n0); else if ((MODE) == 2) dr = il1(n0) + 128; \
        else dr = (n0 < 1024) ? 2048 + n0 : ((n0 < 2048) ? il1(n0 - 1024) : il1(n0 - 2048) + 128); \
        transpose_item((SRC), (NN), kb * 64, n0, (bf16_t*)(DST), (KK), dr + (ROFF), scr, lane); return; } it -= (cnt);
    WITEM(1536, a.mix_w_in, 1024, MIXN, 96, ws + W_MIX, 0, 0)
    WITEM(512, a.mix_w_out, 1024, 1024, 32, ws + W_OUT, 0, 0)
    WITEM(1408, a.ffn_w1, 1024, DFF, 88, ws + W_F13, 1, 0)
    WITEM(1408, a.ffn_w3, 1024, DFF, 88, ws + W_F13, 2, 0)
    WITEM(1408, a.ffn_w2, DFF, 1024, 32, ws + W_F2, 0, 0)
    WITEM(1536, a.conv_w_in, 1024, 3072, 96, ws + W_CIN, 3, 0)
    WITEM(512, a.conv_w_out, 1024, 1024, 32, ws + W_COUT, 0, 0)
    { const int e = it / 1408; if (e < 8) { int it2 = it % 1408; const int bi_ = it2 >> 3, kb = bi_ % 16, nb = (bi_ / 16) * 8 + (it2 & 7), n0 = nb * 32;
        transpose_item(a.exp_w1 + (size_t)e * 1024 * DFF, DFF, kb * 64, n0, (bf16_t*)(ws + W_E13), 1024, il1(n0) + e * 2 * DFF, scr, lane); return; } it -= 8 * 1408; }
    { const int e = it / 1408; if (e < 8) { int it2 = it % 1408; const int bi_ = it2 >> 3, kb = bi_ % 16, nb = (bi_ / 16) * 8 + (it2 & 7), n0 = nb * 32;
        transpose_item(a.exp_w3 + (size_t)e * 1024 * DFF, DFF, kb * 64, n0, (bf16_t*)(ws + W_E13), 1024, il1(n0) + 128 + e * 2 * DFF, scr, lane); return; } it -= 8 * 1408; }
    { const int e = it / 1408; if (e < 8) { int it2 = it % 1408; const int bi_ = it2 >> 3, kb = bi_ % 44, nb = (bi_ / 44) * 8 + (it2 & 7), n0 = nb * 32;
        transpose_item(a.exp_w2 + (size_t)e * DFF * 1024, 1024, kb * 64, n0, (bf16_t*)(ws + W_E2), DFF, n0 + e * 1024, scr, lane); return; } it -= 8 * 1408; }
    { const int w = it / 256; if (w < 2) { int it2 = it % 256; const int kb = it2 >> 3, nb = it2 & 7, n0 = nb * 32;
        transpose_item(a.cmp_w1 + (size_t)w * 2048 * 256, 256, kb * 64, n0, (bf16_t*)(ws + W_C1), 2048, n0 + w * 256, scr, lane); return; } it -= 512; }
    { const int w = it / 32; if (w < 2) { int it2 = it % 32; const int kb = it2 >> 3, nb = it2 & 7, n0 = nb * 32;
        transpose_item(a.cmp_w2 + (size_t)w * 256 * 64, 64, kb * 64, n0, (bf16_t*)(ws + W_C2), 256, n0 + w * 256, scr, lane); return; } }
#undef WITEM
}
constexpr int N_WITEMS = 1536 + 512 + 1408 * 3 + 1536 + 512 + 3 * 8 * 1408 + 512 + 64;

template <int NB>
__device__ __forceinline__ void gemv_block(LAS float* sv, LAS float* part, const float* W, int K, int N, int j0, const float* bias, float* out, int out_pitch, int tid) {
    const int wid = tid >> 6, lane = tid & 63, kc = K / 8, kb = wid * kc;
    float acc[NB];
#pragma unroll
    for (int b = 0; b < NB; ++b) acc[b] = 0.f;
    const float* wp = W + (size_t)kb * N + j0 + lane;
    for (int k0 = 0; k0 < kc; k0 += 16) {
        float wv[16];
#pragma unroll
        for (int j = 0; j < 16; ++j) wv[j] = wp[(size_t)(k0 + j) * N];
#pragma unroll
        for (int j = 0; j < 16; ++j)
#pragma unroll
            for (int b = 0; b < NB; ++b) acc[b] += sv[b * K + kb + k0 + j] * wv[j]; }
#pragma unroll
    for (int b = 0; b < NB; ++b) part[(wid * NB + b) * 64 + lane] = acc[b];
    __syncthreads();
    for (int idx = tid; idx < NB * 64; idx += 512) { const int b = idx >> 6, l = idx & 63; float s = 0.f;
#pragma unroll
        for (int w = 0; w < 8; ++w) s += part[(w * NB + b) * 64 + l];
        if (bias) s += bias[j0 + l];
        out[(size_t)b * out_pitch + j0 + l] = s; }
    __syncthreads();
}

__device__ __forceinline__ void phase_prologue(const Args& a, LAS unsigned char* lds, int tid) {
    const int wid = tid >> 6, lane = tid & 63, G = gridDim.x, bx = blockIdx.x;
    LAS float* sv = (LAS float*)lds;
    LAS float* part = (LAS float*)(lds + 65536);
    float* MOD = (float*)(a.ws + WS_MOD); float* CB = (float*)(a.ws + WS_CBIAS);
    bool have_silu = false;
    __syncthreads();
    for (int item = bx; item < 200; item += G) {
        if (item < 192) {
            if (!have_silu) { for (int i = tid; i < 16 * 1024; i += 512) sv[i] = silu_f(a.c[i]); __syncthreads(); have_silu = true; }
            const int li = item / 96, jg = item % 96;
            gemv_block<16>(sv, part, a.ada_w + (size_t)li * 1024 * 6144, 1024, 6144, jg * 64, a.ada_b + li * 6144, MOD + (size_t)li * 16 * 6144, 6144, tid);
        } else {
            const int q = item - 192, w = q >> 2, jg = q & 3;
            __syncthreads();
            for (int i = tid; i < 2048; i += 512) sv[i] = a.cmp_pos[w * 2048 + i];
            __syncthreads(); have_silu = false;
            gemv_block<1>(sv, part, a.cmp_w1 + (size_t)w * 2048 * 256, 2048, 256, jg * 64, nullptr, CB + w * 256, 256, tid);
        }
    }
    __syncthreads();
    if (bx == G - 1) for (int i = tid; i < 65536 / 16; i += 512) *(u32x4*)(a.ws + R3_KCPAD + (size_t)i * 16) = (u32x4){0u, 0u, 0u, 0u};
    LAS float* scr = (LAS float*)(lds + wid * 16384);
    { constexpr int NBI = N_WITEMS / 8; unsigned* head = (unsigned*)(a.ws + WS_CTL) + CW_WQ + 256; volatile LAS unsigned* wqw = (volatile LAS unsigned*)(lds + MISC_OFF + 128);
      for (;;) { __syncthreads(); if (tid == 0) *wqw = atomicAdd(head, 1u); __syncthreads(); const int bi = (int)*wqw; if (bi >= NBI) break;
          weight_item(a, bi * 8 + wid, scr, lane); } }
}

__device__ __forceinline__ void phase_modulate(const float* x, const float* sc, const float* sh, bf16_t* h, int tid) {
    const int wid = tid >> 6, lane = tid & 63;
    for (int row = blockIdx.x * 8 + wid; row < MTOK; row += gridDim.x * 8) { const int b = row >> 11;
#pragma unroll
        for (int j = 0; j < 4; ++j) { const int c = 4 * lane + 256 * j; const f32x4 v = *(const f32x4*)(x + (size_t)row * DM + c);
            const f32x4 s = *(const f32x4*)(sc + b * 6144 + c), t = *(const f32x4*)(sh + b * 6144 + c); const f32x4 o = v * (s + 1.0f) + t;
            u32x2 w; w.x = cvt_pk_bf16(o[0], o[1]); w.y = cvt_pk_bf16(o[2], o[3]); *(u32x2*)(h + (size_t)row * DM + c) = w; } }
}
template <bool HAS_Y, bool HAS_H, bool ROUTER>
__device__ __forceinline__ void phase_ln(const float* xin, float xscale, const bf16_t* y, const float* gate, const float* lg, const float* lb, float* xout,
                                         bf16_t* hout, const float* sc, const float* sh, const float* rw, const float* rb, unsigned* ecnt, int* asg, float* agate, int tid) {
    const int wid = tid >> 6, lane = tid & 63;
    for (int row = blockIdx.x * 8 + wid; row < MTOK; row += gridDim.x * 8) { const int b = row >> 11;
        f32x4 v[4]; float s = 0.f;
#pragma unroll
        for (int j = 0; j < 4; ++j) { const int c = 4 * lane + 256 * j; v[j] = *(const f32x4*)(xin + (size_t)row * DM + c) * xscale;
            if (HAS_Y) { const u32x2 yw = *(const u32x2*)(y + (size_t)row * DM + c); const f32x4 gg = *(const f32x4*)(gate + b * 6144 + c);
                const f32x4 yv = (f32x4){bflo(yw.x), bfhi(yw.x), bflo(yw.y), bfhi(yw.y)}; v[j] += (gg + 1.0f) * yv; }
            s += (v[j][0] + v[j][1]) + (v[j][2] + v[j][3]); }
        const float mean = wave_sum(s) * (1.0f / DM); float s2 = 0.f;
#pragma unroll
        for (int j = 0; j < 4; ++j) { v[j] = v[j] - mean; s2 += (v[j][0] * v[j][0] + v[j][1] * v[j][1]) + (v[j][2] * v[j][2] + v[j][3] * v[j][3]); }
        const float rstd = 1.0f / sqrtf(wave_sum(s2) * (1.0f / DM) + LN_EPS);
        float lgt[8];
#pragma unroll
        for (int e = 0; e < 8; ++e) lgt[e] = 0.f;
#pragma unroll
        for (int j = 0; j < 4; ++j) { const int c = 4 * lane + 256 * j; const f32x4 g4 = *(const f32x4*)(lg + c), b4 = *(const f32x4*)(lb + c);
            const f32x4 xo = v[j] * rstd * g4 + b4; *(f32x4*)(xout + (size_t)row * DM + c) = xo;
            if (HAS_H) { const f32x4 s4 = *(const f32x4*)(sc + b * 6144 + c), t4 = *(const f32x4*)(sh + b * 6144 + c); const f32x4 hv = xo * (s4 + 1.0f) + t4;
                u32x2 w; w.x = cvt_pk_bf16(hv[0], hv[1]); w.y = cvt_pk_bf16(hv[2], hv[3]); *(u32x2*)(hout + (size_t)row * DM + c) = w;
                if (ROUTER) {
#pragma unroll
                    for (int q = 0; q < 4; ++q) { const f32x4 r0 = *(const f32x4*)(rw + (size_t)(c + q) * 8), r1 = *(const f32x4*)(rw + (size_t)(c + q) * 8 + 4);
#pragma unroll
                        for (int e = 0; e < 4; ++e) { lgt[e] += hv[q] * r0[e]; lgt[4 + e] += hv[q] * r1[e]; } } } } }
        if (ROUTER) {
#pragma unroll
            for (int e = 0; e < 8; ++e) lgt[e] = wave_sum(lgt[e]) + rb[e];
            int i1 = 0; float l1 = lgt[0];
#pragma unroll
            for (int e = 1; e < 8; ++e) if (lgt[e] > l1) { l1 = lgt[e]; i1 = e; }
            int i2 = -1; float l2 = -3.0e38f;
#pragma unroll
            for (int e = 0; e < 8; ++e) if (e != i1 && lgt[e] > l2) { l2 = lgt[e]; i2 = e; }
            const float ex = __expf(l2 - l1), den = 1.0f / (1.0f + ex);
            if (lane == 0) {
                const unsigned r1 = atomicAdd(ecnt + 64 * i1, 1u), r2 = atomicAdd(ecnt + 64 * (8 + i2), 1u);
                asg[row] = (i1 << 20) | (int)r1; asg[MTOK + row] = (i2 << 20) | (int)r2; agate[row] = den; agate[MTOK + row] = ex * den; }
        }
    }
}
__device__ __forceinline__ void phase_conv(const bf16_t* Z, const bf16_t* GB, const float* taps, bf16_t* A, int tid) {
    const int wid = tid >> 6, lane = tid & 63;
    for (int row = blockIdx.x * 8 + wid; row < MTOK; row += gridDim.x * 8) { const int t = row & 2047;
#pragma unroll
        for (int j = 0; j < 2; ++j) { const int c = 8 * lane + 512 * j;
            const u32x4 z2 = *(const u32x4*)(Z + (size_t)row * DM + c), gb = *(const u32x4*)(GB + (size_t)row * DM + c);
            u32x4 z1 = (u32x4){0u, 0u, 0u, 0u}, z0 = z1;
            if (t >= 1) z1 = *(const u32x4*)(Z + (size_t)(row - 1) * DM + c);
            if (t >= 2) z0 = *(const u32x4*)(Z + (size_t)(row - 2) * DM + c);
            u32x4 o;
#pragma unroll
            for (int q = 0; q < 4; ++q) { const int cc = c + 2 * q;
                const float a0 = bflo(gb[q]) * (taps[cc] * bflo(z0[q]) + taps[1024 + cc] * bflo(z1[q]) + taps[2048 + cc] * bflo(z2[q]));
                const float a1 = bfhi(gb[q]) * (taps[cc + 1] * bfhi(z0[q]) + taps[1024 + cc + 1] * bfhi(z1[q]) + taps[2048 + cc + 1] * bfhi(z2[q]));
                o[q] = cvt_pk_bf16(a0, a1); }
            *(u32x4*)(A + (size_t)row * DM + c) = o; } }
}
__device__ __forceinline__ void phase_moe_rows(unsigned char* ws, int tid) {
    unsigned* ctl = (unsigned*)(ws + WS_CTL); const int* asg = (const int*)(ws + WS_ASG); const float* agate = (const float*)(ws + WS_AGATE);
    int* rowtok = (int*)(ws + WS_ROWTOK); float* rowgate = (float*)(ws + WS_ROWGATE);
    int cnt[2][8], pst[2][8];
#pragma unroll
    for (int k = 0; k < 2; ++k) { int run = 0;
#pragma unroll
        for (int e = 0; e < 8; ++e) { cnt[k][e] = (int)xb_ld(ctl + CW_ECNT + 64 * (8 * k + e)); pst[k][e] = run; run += ((cnt[k][e] + 255) >> 8) << 8; } }
    const int gt = blockIdx.x * 512 + tid, GT = gridDim.x * 512;
    for (int idx = gt; idx < 2 * MTOK; idx += GT) { const int k = idx >= MTOK ? 1 : 0, tok = idx - k * MTOK; const int a = asg[idx], e = a >> 20, rk = a & 0xfffff;
        int ps = 0;
#pragma unroll
        for (int q = 0; q < 8; ++q) ps = (q == e) ? pst[k][q] : ps;
        const int row = ps + rk; rowtok[k * MOE_ROWS + row] = tok; rowgate[k * MOE_ROWS + row] = agate[idx]; }
    for (int idx = gt; idx < 2 * 8 * 256; idx += GT) { const int k = idx >> 11, e = (idx >> 8) & 7, q = idx & 255; int c = 0, ps = 0;
#pragma unroll
        for (int w = 0; w < 8; ++w) { c = (w == e) ? cnt[k][w] : c; ps = (w == e) ? pst[k][w] : ps; }
        const int row = ps + c + q, end = ps + (((c + 255) >> 8) << 8);
        if (row < end) { rowtok[k * MOE_ROWS + row] = -1; rowgate[k * MOE_ROWS + row] = 0.f; } }
    if (blockIdx.x == 0 && tid < 16) { const int k = tid >> 3, e = tid & 7; int te = 0;
#pragma unroll
        for (int w = 0; w < 8; ++w) if (w <= e) te += (cnt[k][w] + 255) >> 8;
        ctl[CW_TEND + 8 * k + e] = (unsigned)te; }
}

typedef short v4i16_t __attribute__((ext_vector_type(4)));
__device__ __forceinline__ f32x16 mfma32(bf16x8 a, bf16x8 b, f32x16 c) { return __builtin_amdgcn_mfma_f32_32x32x16_bf16(a, b, c, 0, 0, 0); }
__device__ __forceinline__ int crow(int r, int hi) { return (r & 3) + 8 * (r >> 2) + 4 * hi; }
__device__ __forceinline__ float xhalf_max(float v) { auto rr = __builtin_amdgcn_permlane32_swap(__float_as_uint(v), __float_as_uint(v), false, false); return fmaxf(__uint_as_float(rr[0]), __uint_as_float(rr[1])); }
__device__ __forceinline__ float xhalf_sum(float v) { auto rr = __builtin_amdgcn_permlane32_swap(__float_as_uint(v), __float_as_uint(v), false, false); return __uint_as_float(rr[0]) + __uint_as_float(rr[1]); }
struct KVStage { u32x4 k, v; };
__device__ __forceinline__ void kv_load(KVStage& s, const bf16_t* Kg, const bf16_t* Vg, int pitch, int key0, int wid, int lane) {
    s.k = *(const u32x4*)(Kg + (size_t)(key0 + lane) * pitch + wid * 8);
    s.v = *(const u32x4*)(Vg + (size_t)(key0 + 16 * (wid & 3) + (lane >> 2)) * pitch + (wid >> 2) * 32 + (lane & 3) * 8);
}
__device__ __forceinline__ void kv_store(const KVStage& s, LAS unsigned char* buf, int wid, int lane) {
    *(LAS u32x4*)(buf + wid * 1024 + lane * 16) = s.k;
    *(LAS u32x4*)(buf + 8192 + wid * 1024 + lane * 16) = s.v;
}
__device__ __forceinline__ void qk_tile(f32x16& s0, f32x16& s1, const LAS unsigned char* kb, const bf16x8 (&qr)[4], int r32, int hi) {
    s0 = (f32x16){}; s1 = (f32x16){};
#pragma unroll
    for (int d0 = 0; d0 < 4; ++d0) { const LAS unsigned char* p = kb + (2 * d0 + hi) * 1024 + r32 * 16;
        const bf16x8 k0 = *(const LAS bf16x8*)p, k1 = *(const LAS bf16x8*)(p + 512);
        s0 = mfma32(k0, qr[d0], s0); s1 = mfma32(k1, qr[d0], s1); }
}
__device__ __forceinline__ void pack_p(bf16x8 (&pb)[4], const f32x16& p0, const f32x16& p1) {
    u32x4 w;
    w.x = cvt_pk_bf16(p0[0], p0[1]); w.y = cvt_pk_bf16(p0[2], p0[3]); w.z = cvt_pk_bf16(p0[4], p0[5]); w.w = cvt_pk_bf16(p0[6], p0[7]); pb[0] = __builtin_bit_cast(bf16x8, w);
    w.x = cvt_pk_bf16(p0[8], p0[9]); w.y = cvt_pk_bf16(p0[10], p0[11]); w.z = cvt_pk_bf16(p0[12], p0[13]); w.w = cvt_pk_bf16(p0[14], p0[15]); pb[1] = __builtin_bit_cast(bf16x8, w);
    w.x = cvt_pk_bf16(p1[0], p1[1]); w.y = cvt_pk_bf16(p1[2], p1[3]); w.z = cvt_pk_bf16(p1[4], p1[5]); w.w = cvt_pk_bf16(p1[6], p1[7]); pb[2] = __builtin_bit_cast(bf16x8, w);
    w.x = cvt_pk_bf16(p1[8], p1[9]); w.y = cvt_pk_bf16(p1[10], p1[11]); w.z = cvt_pk_bf16(p1[12], p1[13]); w.w = cvt_pk_bf16(p1[14], p1[15]); pb[3] = __builtin_bit_cast(bf16x8, w);
}
__device__ __forceinline__ void pv_tile(f32x16& o0, f32x16& o1, const LAS unsigned char* vbuf, const bf16x8 (&pb)[4], int lane) {
    const int i = lane & 15, hi = lane >> 5;
    const LAS unsigned char* vb = vbuf + ((lane >> 4) & 1) * 32 + (i & 3) * 8 + (4 * hi + (i >> 2)) * 64;
#pragma unroll
    for (int ks = 0; ks < 4; ++ks) {
        const v4i16_t a0 = __builtin_amdgcn_ds_read_tr16_b64_v4i16((LAS v4i16_t*)(vb + ks * 1024));
        const v4i16_t a1 = __builtin_amdgcn_ds_read_tr16_b64_v4i16((LAS v4i16_t*)(vb + ks * 1024 + 512));
        const v4i16_t c0 = __builtin_amdgcn_ds_read_tr16_b64_v4i16((LAS v4i16_t*)(vb + 4096 + ks * 1024));
        const v4i16_t c1 = __builtin_amdgcn_ds_read_tr16_b64_v4i16((LAS v4i16_t*)(vb + 4096 + ks * 1024 + 512));
        const bf16x8 va = (bf16x8){a0[0], a0[1], a0[2], a0[3], a1[0], a1[1], a1[2], a1[3]};
        const bf16x8 vc = (bf16x8){c0[0], c0[1], c0[2], c0[3], c1[0], c1[1], c1[2], c1[3]};
        o0 = mfma32(va, pb[ks], o0); o1 = mfma32(vc, pb[ks], o1); }
}
__device__ __forceinline__ void store_ot(LAS unsigned char* stg, const f32x16& o0, const f32x16& o1, bf16_t* Og, int pitch, int lane) {
    const int r32 = lane & 31, hi = lane >> 5;
#pragma unroll
    for (int r = 0; r < 16; r += 2) { const int d = crow(r, hi);
        *(LAS unsigned*)(stg + r32 * 128 + d * 2) = cvt_pk_bf16(o0[r], o0[r + 1]);
        *(LAS unsigned*)(stg + r32 * 128 + 64 + d * 2) = cvt_pk_bf16(o1[r], o1[r + 1]); }
    asm volatile("s_waitcnt lgkmcnt(0)" ::: "memory");
#pragma unroll
    for (int i = 0; i < 4; ++i) { const int row = i * 8 + (lane >> 3), ch = lane & 7; const u32x4 v = *(const LAS u32x4*)(stg + row * 128 + ch * 16);
        *(u32x4*)(Og + (size_t)row * pitch + ch * 8) = v; }
    asm volatile("s_waitcnt lgkmcnt(0)" ::: "memory");
}

#define CK(a, r) (32 * (a) + ((r) & 3) + 8 * ((r) >> 2))
constexpr int ATT_RING = 0, ATT_SLOT = 16384, ATT_IMP = 65536, ATT_SEL = ATT_IMP + 4 * 64 * 33 * 4, ATT_DONE = ATT_SEL + 256, ATT_WQ = ATT_DONE + 64;
__device__ __forceinline__ int wq_next(unsigned* head, LAS unsigned char* lds, int tid) {
    __syncthreads();
    if (tid == 0) *(volatile LAS unsigned*)(lds + ATT_WQ) = atomicAdd(head, 1u);
    __syncthreads();
    return (int)*(volatile LAS unsigned*)(lds + ATT_WQ);
}
__device__ __forceinline__ void glds16(const void* gsrc, unsigned lds_dst) { unsigned keep;
    asm volatile("s_mov_b32 %0, m0\n\ts_mov_b32 m0, %2\n\ts_nop 0\n\tglobal_load_lds_dwordx4 %1, off\n\ts_mov_b32 m0, %0" : "=&s"(keep) : "v"(gsrc), "s"(lds_dst) : "memory"); }
__device__ __forceinline__ void kv_dma(LAS unsigned char* slot, const bf16_t* Kg, const bf16_t* Vg, int pitch, int key0, int wid, int lane) {
    const bf16_t* kp = Kg + (size_t)(key0 + lane) * pitch + wid * 8;
    const bf16_t* vp = Vg + (size_t)(key0 + 16 * (wid & 3) + (lane >> 2)) * pitch + (wid >> 2) * 32 + (lane & 3) * 8;
    const unsigned dst = (unsigned)__builtin_amdgcn_readfirstlane((int)(unsigned)(uintptr_t)(slot + wid * 1024));
    glds16(kp, dst); glds16(vp, dst + 8192u);
}
__device__ __forceinline__ void kv_dma_img(LAS unsigned char* slot, const unsigned char* Kimg, const unsigned char* Vimg, int wid, int lane) {
    const unsigned dst = (unsigned)__builtin_amdgcn_readfirstlane((int)(unsigned)(uintptr_t)(slot + wid * 1024));
    glds16(Kimg + wid * 1024 + lane * 16, dst); glds16(Vimg + wid * 1024 + lane * 16, dst + 8192u);
}
__device__ __forceinline__ void wait_bar(int ny) {
    if (ny >= 2) asm volatile("s_waitcnt vmcnt(4) lgkmcnt(0)\n\ts_barrier" ::: "memory");
    else if (ny == 1) asm volatile("s_waitcnt vmcnt(2) lgkmcnt(0)\n\ts_barrier" ::: "memory");
    else asm volatile("s_waitcnt vmcnt(0) lgkmcnt(0)\n\ts_barrier" ::: "memory");
}

constexpr float SB_DONE = 160.0f;
__device__ __forceinline__ void sb_unit(LAS unsigned char* lds, const bf16_t* Q, const unsigned char* SBK, const unsigned char* SBV, bf16_t* O, int b, int h, int qb, int wid, int lane) {
    const int r32 = lane & 31, hi = lane >> 5;
    const int qw = qb * 256 + wid * 32, tq = qw + r32;
    const bf16_t* Qp = Q + (size_t)(b * SEQ + tq) * DM + h * 64;
    bf16x8 qr[4];
#pragma unroll
    for (int d0 = 0; d0 < 4; ++d0) qr[d0] = *(const bf16x8*)(Qp + d0 * 16 + hi * 8);
    asm volatile("" : "+v"(qr[0]), "+v"(qr[1]), "+v"(qr[2]), "+v"(qr[3]));
    const unsigned char* Kimg = SBK + (size_t)((b * 8 + h) * 32) * 8192; const unsigned char* Vimg = SBV + (size_t)((b * 8 + h) * 32) * 8192;
    f32x16 o0 = (f32x16){}, o1 = (f32x16){}; float C = 0.f;
    const int nel = 4 * (qb + 1);
    LAS unsigned char* ring = lds + ATT_RING; LAS unsigned* DONE = (LAS unsigned*)(lds + ATT_DONE);
#pragma unroll
    for (int e = 0; e < 3; ++e) if (e < nel) kv_dma_img(ring + e * ATT_SLOT, Kimg + (size_t)(nel - 1 - e) * 8192, Vimg + (size_t)(nel - 1 - e) * 8192, wid, lane);
    bool wdone = false;
    for (int i = 0; i < nel; ++i) {
        const int jt = nel - 1 - i; const int li = (i + 2 < nel - 1) ? i + 2 : nel - 1;
        wait_bar(li - i);
        if (i > 0) { const unsigned f = DONE[(i & 1) * 8 + (lane & 7)]; if (__all(f != 0u)) break; }
        if (i + 3 < nel) kv_dma_img(ring + ((i + 3) & 3) * ATT_SLOT, Kimg + (size_t)(nel - 4 - i) * 8192, Vimg + (size_t)(nel - 4 - i) * 8192, wid, lane);
        const LAS unsigned char* buf = ring + (i & 3) * ATT_SLOT;
        if (!wdone && 64 * jt <= qw + 30) {
            f32x16 s0, s1; qk_tile(s0, s1, buf, qr, r32, hi);
            u32x4 wh[4], wl[4]; f32x2 tot2 = (f32x2){0.f, 0.f}; float tot;
            const int lim = tq - 64 * jt - 4 * hi;
#define SB_SPLUS(z) (fmaxf((z), 0.f) + fast_log2(1.0f + fast_exp2(-fabsf(z))))
#define SB_HI(x) __uint_as_float(__float_as_uint(x) & 0xffff0000u)
#define SB_PAIR(S, A, r, MASKED) do { float pa_ = SB_SPLUS(S[r]), pb2_ = SB_SPLUS(S[(r) + 1]); \
                if (MASKED) { const bool va_ = CK((A), (r)) < lim, vb_ = CK((A), (r) + 1) < lim; S[r] = va_ ? S[r] - pa_ : -1.0e30f; S[(r) + 1] = vb_ ? S[(r) + 1] - pb2_ : -1.0e30f; pa_ = va_ ? pa_ : 0.f; pb2_ = vb_ ? pb2_ : 0.f; } \
                else { S[r] -= pa_; S[(r) + 1] -= pb2_; } \
                tot2 += (f32x2){pa_, pb2_}; \
                wh[2 * (A) + ((r) >> 3)][((r) >> 1) & 3] = (__float_as_uint(pa_) >> 16) | (__float_as_uint(pb2_) & 0xffff0000u); \
                wl[2 * (A) + ((r) >> 3)][((r) >> 1) & 3] = cvt_pk_bf16(pa_ - SB_HI(pa_), pb2_ - SB_HI(pb2_)); } while (0)
            if (64 * jt + 63 < qw) {
#pragma unroll
                for (int r = 0; r < 16; r += 2) { SB_PAIR(s0, 0, r, false); SB_PAIR(s1, 1, r, false); }
            } else {
#pragma unroll
                for (int r = 0; r < 16; r += 2) { SB_PAIR(s0, 0, r, true); SB_PAIR(s1, 1, r, true); }
            }
#undef SB_PAIR
#undef SB_HI
#undef SB_SPLUS
            tot = tot2[0] + tot2[1];
            bf16x8 bh[4], bl[4];
#pragma unroll
            for (int q = 0; q < 4; ++q) { bh[q] = __builtin_bit_cast(bf16x8, wh[q]); bl[q] = __builtin_bit_cast(bf16x8, wl[q]); }
            bf16x8 tri[2], ones;
            { int rr = r32 - 4 * hi; asm volatile("" : "+v"(rr)); unsigned ou = 0x3F803F80u; asm volatile("" : "+v"(ou));
#pragma unroll
              for (int s2 = 0; s2 < 2; ++s2) { u32x4 w;
#pragma unroll
                  for (int q = 0; q < 4; ++q) { const int k0 = 16 * s2 + 8 * (q >> 1) + 2 * (q & 1);
                      w[q] = ((k0 > rr) ? 0x3F80u : 0u) | ((k0 + 1 > rr) ? 0x3F800000u : 0u); }
                  tri[s2] = __builtin_bit_cast(bf16x8, w); }
              ones = __builtin_bit_cast(bf16x8, (u32x4){ou, ou, ou, ou}); }
            f32x16 L0, L1;
#pragma unroll
            for (int r = 0; r < 16; ++r) { L0[r] = C; L1[r] = C; }
            L0 = mfma32(tri[0], bh[0], L0); L0 = mfma32(tri[0], bl[0], L0); L0 = mfma32(tri[1], bh[1], L0); L0 = mfma32(tri[1], bl[1], L0);
            L0 = mfma32(ones, bh[2], L0); L0 = mfma32(ones, bl[2], L0); L0 = mfma32(ones, bh[3], L0); L0 = mfma32(ones, bl[3], L0);
            L1 = mfma32(tri[0], bh[2], L1); L1 = mfma32(tri[0], bl[2], L1); L1 = mfma32(tri[1], bh[3], L1); L1 = mfma32(tri[1], bl[3], L1);
            C += xhalf_sum(tot);
#pragma unroll
            for (int r = 0; r < 16; ++r) { s0[r] = fast_exp2(s0[r] - L0[r]); s1[r] = fast_exp2(s1[r] - L1[r]); }
            bf16x8 pb[4]; pack_p(pb, s0, s1);
            pv_tile(o0, o1, buf + 8192, pb, lane);
            wdone = __all(C > SB_DONE);
        }
        if (lane == 0) DONE[((i + 1) & 1) * 8 + wid] = wdone ? 1u : 0u;
    }
    asm volatile("s_waitcnt vmcnt(0) lgkmcnt(0)\n\ts_barrier" ::: "memory");
    store_ot(ring + wid * 4096, o0, o1, O + (size_t)(b * SEQ + qw) * DM + h * 64, DM, lane);
}

__device__ __forceinline__ void qk_tile_c(f32x16& s0, f32x16& s1, const LAS unsigned char* kb, const bf16x8 (&qr)[4], const f32x16& cini, int r32, int hi) {
    s0 = cini; s1 = cini;
#pragma unroll
    for (int d0 = 0; d0 < 4; ++d0) { const LAS unsigned char* p = kb + (2 * d0 + hi) * 1024 + r32 * 16;
        const bf16x8 k0 = *(const LAS bf16x8*)p, k1 = *(const LAS bf16x8*)(p + 512);
        s0 = mfma32(k0, qr[d0], s0); s1 = mfma32(k1, qr[d0], s1); }
}
#define MAX3(a, b, c) __builtin_fmaxf(__builtin_fmaxf((a), (b)), (c))
constexpr float SM_THR = 8.0f;
#define SM_TILE(buf, c0, MASK, lim_, dbase_, first_) do { \
        f32x16 ci_; _Pragma("unroll") for (int r = 0; r < 16; ++r) ci_[r] = (c0); \
        f32x16 s0_, s1_; qk_tile_c(s0_, s1_, (buf), qr, ci_, r32, hi); \
        if ((MASK) == 1) { _Pragma("unroll") for (int r = 0; r < 16; ++r) { s0_[r] = (CK(0, r) <= (lim_)) ? s0_[r] : -1.0e30f; s1_[r] = (CK(1, r) <= (lim_)) ? s1_[r] : -1.0e30f; } } \
        if ((MASK) == 2) { _Pragma("unroll") for (int r = 0; r < 16; ++r) { s0_[r] = ((unsigned)((dbase_) - CK(0, r)) < 512u) ? s0_[r] : -1.0e30f; s1_[r] = ((unsigned)((dbase_) - CK(1, r)) < 512u) ? s1_[r] : -1.0e30f; } } \
        float ma_ = MAX3(s0_[0], s0_[1], s1_[0]), mb_ = MAX3(s0_[2], s0_[3], s1_[1]); ma_ = MAX3(ma_, s1_[2], s1_[3]); \
        _Pragma("unroll") for (int r = 4; r < 16; r += 4) { ma_ = MAX3(ma_, s0_[r], s0_[r + 1]); mb_ = MAX3(mb_, s0_[r + 2], s0_[r + 3]); ma_ = MAX3(ma_, s1_[r], s1_[r + 1]); mb_ = MAX3(mb_, s1_[r + 2], s1_[r + 3]); } \
        const float mx_ = xhalf_max(fmaxf(ma_, mb_)); \
        if (__any(mx_ > SM_THR) || (first_)) { const float dl_ = (first_) ? fmaxf(mx_, -100.f) : fmaxf(mx_, 0.f), al_ = fast_exp2(-dl_); m_run += dl_; l_run *= al_;   \
            _Pragma("unroll") for (int r = 0; r < 16; ++r) { s0_[r] -= dl_; s1_[r] -= dl_; oa0[r] *= al_; oa1[r] *= al_; } } \
        f32x2 ps_ = (f32x2){0.f, 0.f}; \
        _Pragma("unroll") for (int r = 0; r < 16; ++r) { s0_[r] = fast_exp2(s0_[r]); s1_[r] = fast_exp2(s1_[r]); ps_ += (f32x2){s0_[r], s1_[r]}; } \
        l_run += ps_[0] + ps_[1]; \
        bf16x8 pb_[4]; pack_p(pb_, s0_, s1_); pv_tile(oa0, oa1, (buf) + 8192, pb_, lane); } while (0)

__device__ __forceinline__ void nsa_unit(LAS unsigned char* lds, const bf16_t* Q, const unsigned char* NSAI, const bf16_t* KCV, const float* GATE, bf16_t* O, int b, int g, int tb, int wid, int lane) {
    const int r32 = lane & 31, hi = lane >> 5, rh = wid & 3, th = wid >> 2;
    const int tloc = 32 * th + r32, t = 64 * tb + tloc; const size_t row = (size_t)b * SEQ + t;
    bf16x8 qr[4];
    { const bf16_t* Qp = Q + row * DM + 512 + (g * 4 + rh) * 64;
#pragma unroll
      for (int d0 = 0; d0 < 4; ++d0) qr[d0] = *(const bf16x8*)(Qp + d0 * 16 + hi * 8); }
    const float* gp = GATE + row * 32 + g * 12 + rh * 3;
    float gt0 = gp[0], gt1 = gp[1], gt2 = gp[2];
    asm volatile("" : "+v"(qr[0]), "+v"(qr[1]), "+v"(qr[2]), "+v"(qr[3]), "+v"(gt0), "+v"(gt1), "+v"(gt2));
    f32x16 tot0, tot1;
    LAS unsigned char* ring = lds + ATT_RING;
    const unsigned char* ImS = NSAI + (size_t)(((0 * 16 + b) * 2 + g) * 32) * 8192; const unsigned char* ImW = NSAI + (size_t)(((2 * 16 + b) * 2 + g) * 32) * 8192;
    constexpr size_t VOFF = (size_t)16 * 2 * 32 * 8192;
    const int jw0 = tb >= 8 ? tb - 8 : 0, nwin = tb - jw0 + 1, nel = nwin + tb + 1;
#define EL_DMA(e, slotp) do { const unsigned char* ki_ = ((e) < nwin) ? ImW + (size_t)(jw0 + (e)) * 8192 : ImS + (size_t)((e) - nwin) * 8192; kv_dma_img((slotp), ki_, ki_ + VOFF, wid, lane); } while (0)
    {
        const bf16_t* Kc = KCV + (size_t)((b * 2 + g) * 128) * 64; const bf16_t* Vc = Kc + (size_t)4096 * 64;
        kv_dma(ring, Kc, Vc, 64, 0, wid, lane); kv_dma(ring + ATT_SLOT, Kc, Vc, 64, 64, wid, lane);
        EL_DMA(0, ring + 2 * ATT_SLOT); EL_DMA(1, ring + 3 * ATT_SLOT);
        wait_bar(2);
    }
    {
        f32x16 p[4];
        qk_tile(p[0], p[1], ring, qr, r32, hi); qk_tile(p[2], p[3], ring + ATT_SLOT, qr, r32, hi);
        float mx = -1.0e30f; const int tcmp = t - 31 - 64 * hi;
#pragma unroll
        for (int a = 0; a < 4; ++a)
#pragma unroll
            for (int r = 0; r < 16; ++r) { p[a][r] = (16 * CK(a, r) <= tcmp) ? p[a][r] : -1.0e30f; mx = fmaxf(mx, p[a][r]); }
        mx = fmaxf(xhalf_max(mx), -1.0e29f);
        float ls = 0.f;
#pragma unroll
        for (int a = 0; a < 4; ++a)
#pragma unroll
            for (int r = 0; r < 16; ++r) { p[a][r] = fast_exp2(p[a][r] - mx); ls += p[a][r]; }
        ls = xhalf_sum(ls); const float inv = ls > 0.f ? 1.0f / ls : 0.f;
#pragma unroll
        for (int a = 0; a < 4; ++a)
#pragma unroll
            for (int r = 0; r < 16; ++r) p[a][r] *= inv;
        LAS float* impw = (LAS float*)(lds + ATT_IMP) + (rh * 64 + tloc) * 33;
        float carry = 0.f;
#pragma unroll
        for (int a = 0; a < 4; ++a) {
            const float e0 = __shfl_xor(p[a][3], 32), e1 = __shfl_xor(p[a][7], 32), e2 = __shfl_xor(p[a][11], 32), e3 = __shfl_xor(p[a][15], 32);
            const float o0 = (p[a][0] + p[a][1]) + (p[a][2] + p[a][3]), o1 = (p[a][4] + p[a][5]) + (p[a][6] + p[a][7]);
            const float o2 = (p[a][8] + p[a][9]) + (p[a][10] + p[a][11]), o3 = (p[a][12] + p[a][13]) + (p[a][14] + p[a][15]);
            impw[8 * a + 0 + hi] = o0 + (hi ? e0 : carry);
            impw[8 * a + 2 + hi] = o1 + (hi ? e1 : e0);
            impw[8 * a + 4 + hi] = o2 + (hi ? e2 : e1);
            impw[8 * a + 6 + hi] = o3 + (hi ? e3 : e2);
            carry = e3; }
#pragma unroll
        for (int a = 0; a < 4; ++a)
#pragma unroll
            for (int r = 0; r < 16; ++r) p[a][r] *= gt0;
        tot0 = (f32x16){}; tot1 = (f32x16){};
        { bf16x8 pb[4]; pack_p(pb, p[0], p[1]); pv_tile(tot0, tot1, ring + 8192, pb, lane); }
        { bf16x8 pb[4]; pack_p(pb, p[2], p[3]); pv_tile(tot0, tot1, ring + ATT_SLOT + 8192, pb, lane); }
    }
    f32x16 oa0 = (f32x16){}, oa1 = (f32x16){}; float m_run = 0.f, l_run = 0.f; unsigned selmask = 0u;
    for (int i = 0; i < nel; ++i) {
        const int li = (i == 0) ? 1 : ((i + 2 < nel - 1) ? i + 2 : nel - 1);
        wait_bar(li - i);
        if (i == 0) { if (2 < nel) EL_DMA(2, ring); if (3 < nel) EL_DMA(3, ring + ATT_SLOT); }
        else if (i + 3 < nel) EL_DMA(i + 3, ring + ((i + 5) & 3) * ATT_SLOT);
        if (i == 0) {
            const LAS float* imp = (const LAS float*)(lds + ATT_IMP);
            LAS unsigned* SEL = (LAS unsigned*)(lds + ATT_SEL);
#pragma unroll 1
            for (int it = 0; it < 4; ++it) { const int tl = 8 * wid + 2 * it + hi, sb = r32;
                const float v = ((imp[(0 * 64 + tl) * 33 + sb] + imp[(1 * 64 + tl) * 33 + sb]) + imp[(2 * 64 + tl) * 33 + sb]) + imp[(3 * 64 + tl) * 33 + sb];
                const bool valid = sb <= tb, forced = (sb == 0) || (sb == tb) || (sb == tb - 1);
                const float val = valid ? (forced ? 1.0e30f : v) : -1.0e30f;
                int rank = 0;
#pragma unroll 8
                for (int s2 = 0; s2 < 32; ++s2) { const float o = __shfl(val, (lane & 32) | s2); rank += ((o > val) || (o == val && s2 < sb)) ? 1 : 0; }
                const unsigned long long bal = __ballot(rank < 16);
                if (lane == 0) { SEL[8 * wid + 2 * it] = (unsigned)bal; SEL[8 * wid + 2 * it + 1] = (unsigned)(bal >> 32); } }
        }
        if (i == nwin) {
            const float lt = xhalf_sum(l_run); const float sc = (lt > 0.f ? 1.0f / lt : 0.f) * gt2;
#pragma unroll
            for (int r = 0; r < 16; ++r) { tot0[r] += sc * oa0[r]; tot1[r] += sc * oa1[r]; oa0[r] = 0.f; oa1[r] = 0.f; }
            m_run = 0.f; l_run = 0.f;
            selmask = *(const LAS unsigned*)(lds + ATT_SEL + tloc * 4);
        }
        const LAS unsigned char* buf = ring + ((i + 2) & 3) * ATT_SLOT;
        if (i < nwin) { const int j = jw0 + i; const int dbase = 64 * (tb - j) + tloc - 4 * hi;
            if (j == tb || (tb >= 8 && j == jw0)) SM_TILE(buf, -m_run, 2, 0, dbase, i == 0);
            else SM_TILE(buf, -m_run, 0, 0, 0, i == 0);
        } else { const int j = i - nwin; const bool rs = (selmask >> j) & 1u;
            if (j == tb) { const int lim = tloc - 4 * hi; SM_TILE(buf, -m_run, 1, lim, 0, j == 0); }
            else { const float c0 = rs ? -m_run : -1.0e30f; SM_TILE(buf, c0, 0, 0, 0, j == 0); }
        }
    }
    { const float lt = xhalf_sum(l_run); const float sc = (lt > 0.f ? 1.0f / lt : 0.f) * gt1;
#pragma unroll
      for (int r = 0; r < 16; ++r) { tot0[r] += sc * oa0[r]; tot1[r] += sc * oa1[r]; } }
    asm volatile("s_waitcnt vmcnt(0) lgkmcnt(0)\n\ts_barrier" ::: "memory");
    store_ot(ring + wid * 4096, tot0, tot1, O + ((size_t)b * SEQ + 64 * tb + 32 * th) * DM + 512 + (g * 4 + rh) * 64, DM, lane);
#undef EL_DMA
}
#undef SM_TILE
#undef MAX3

#ifndef PHSEL
#define PHSEL 0xffffffffu
#endif
#ifndef ATTREP
#define ATTREP 1
#endif
#ifndef REPMASK
#define REPMASK 0u
#endif
#define PH(n) _Pragma("unroll") for (int rep_ = 0; rep_ < (int)(((PHSEL >> (n)) & 1u) + ((REPMASK >> (n)) & 1u)); ++rep_)
__global__ void __launch_bounds__(512, 2) hybrid_fwd(Args a) {
    extern __shared__ __attribute__((aligned(16))) unsigned char lds_raw[];
    LAS unsigned char* lds = (LAS unsigned char*)lds_raw;
    const int tid0 = threadIdx.x;
    const int G = gridDim.x, bx = blockIdx.x;
    unsigned char* ws = a.ws;
    unsigned* ctl = (unsigned*)(ws + WS_CTL);
    volatile LAS unsigned* MISC = (volatile LAS unsigned*)(lds + MISC_OFF);
    if (tid0 < 32) MISC[tid0] = 0u;
    __syncthreads();
    XcdBarrier bar = xcd_barrier_post(ctl + CW_BAR, MISC + 8);
    if (tid0 == 0) MISC[24] = atomicAdd(ctl + CW_XRANK + 64 * bar.x, 1u);
#define GRID_BAR() xcd_barrier(bar)
    float* MOD = (float*)(ws + WS_MOD);
    const float* MOD0 = MOD; const float* MOD1 = MOD + 16 * 6144;
    bf16_t* R1 = (bf16_t*)(ws + WS_R1); bf16_t* R2 = (bf16_t*)(ws + WS_R2); bf16_t* R3 = (bf16_t*)(ws + WS_R3);
    bf16_t* KC = (bf16_t*)(ws + R3_KC); float* GATE = (float*)(ws + R3_GATE); bf16_t* HID = (bf16_t*)(ws + R3_HID); bf16_t* KCV = (bf16_t*)(ws + R3_KCV);

    PH(0) phase_prologue(a, lds, opaque_tid());
    GRID_BAR();
    { if (tid0 == 0) { unsigned base = 0u, mine = 1u;
          for (unsigned j = 0; j < 16; ++j) { const unsigned cn = xb_ld(ctl + CW_XRANK + 64 * j); if (j < bar.x) base += cn; if (j == bar.x) mine = cn; }
          MISC[25] = base; MISC[26] = mine; }
      __syncthreads(); }
#define XPLACE() (XcdPlace{__builtin_amdgcn_readfirstlane((int)MISC[25]), __builtin_amdgcn_readfirstlane((int)MISC[26]), __builtin_amdgcn_readfirstlane((int)MISC[24]), (int)gridDim.x})
    PH(1) phase_modulate(a.x, MOD0 + 1024, MOD0, R1, opaque_tid());
    GRID_BAR();
    PH(2) { pg8::Gemm g{R1, (const bf16_t*)(ws + W_MIX), DM, DM, nullptr}; GridOrder S; S.init(MTOK / 256, MIXNP / 256, XPLACE());
      EpiMix E{(bf16_t*)(ws + R2_Q), ws + R2_SBK, ws + R2_SBV, ws + R2_NSA, KC, GATE};
      pg8::gemm_phase<EpiMix, GridOrder, true, false>(lds, g, S, E); }
    GRID_BAR();
    PH(3) if (bx < 32) {
        { pg8::Gemm g{KC, (const bf16_t*)(ws + W_C1), 1024, 2048, nullptr}; CmpOrder S{G, bx};
          EpiPlain<1> E{HID, 256, (const float*)(ws + WS_CBIAS), 256, 1};
          pg8::gemm_phase<EpiPlain<1>, CmpOrder, false, false>(lds, g, S, E); }
        asm volatile("s_waitcnt vmcnt(0)" ::: "memory"); __syncthreads();
        __builtin_amdgcn_fence(__ATOMIC_ACQUIRE, "agent"); asm volatile("s_waitcnt vmcnt(0)" ::: "memory"); __syncthreads();
        { pg8::Gemm g{HID, (const bf16_t*)(ws + W_C2), 256, 256, nullptr}; CmpOrder S{G, bx};
          EpiPlain<0> E{KCV, 64, nullptr, 64, 1};
          pg8::gemm_phase<EpiPlain<0>, CmpOrder, false, false>(lds, g, S, E); }
    }
    PH(4) { const int tid = opaque_tid(), lane = tid & 63, wid = __builtin_amdgcn_readfirstlane(tid >> 6);
      for (;;) { const int u = wq_next(ctl + CW_WQ, lds, opaque_tid()); if (u >= 1024) break;
        for (int q_ = 0; q_ < ATTREP; ++q_) { sb_unit(lds, (const bf16_t*)(ws + R2_Q), ws + R2_SBK, ws + R2_SBV, R1, (u & 127) >> 3, u & 7, 7 - (u >> 7), wid, lane); __syncthreads(); } } }
    GRID_BAR();
    PH(5) { const int tid = opaque_tid(), lane = tid & 63, wid = __builtin_amdgcn_readfirstlane(tid >> 6);
      for (;;) { const int u = wq_next(ctl + CW_WQ + 64, lds, opaque_tid()); if (u >= 1024) break;
        for (int q_ = 0; q_ < ATTREP; ++q_) { nsa_unit(lds, (const bf16_t*)(ws + R2_Q), ws + R2_NSA, KCV, GATE, R1, (u & 31) >> 1, u & 1, 31 - (u >> 5), wid, lane); __syncthreads(); } } }
    GRID_BAR();
    PH(6) { pg8::Gemm g{R1, (const bf16_t*)(ws + W_OUT), DM, DM, nullptr}; GridOrder S; S.init(MTOK / 256, 4, XPLACE());
      EpiPlain<0> E{R3, DM, nullptr, DM, 4};
      pg8::gemm_phase<EpiPlain<0>, GridOrder, true, false>(lds, g, S, E); }
    GRID_BAR();
    PH(7) phase_ln<true, true, false>(a.x, DN_ALPHA, R3, MOD0 + 2048, a.ln_g, a.ln_b, a.out, R1, MOD0 + 4096, MOD0 + 3072, nullptr, nullptr, nullptr, nullptr, nullptr, opaque_tid());
    GRID_BAR();
    PH(8) { pg8::Gemm g{R1, (const bf16_t*)(ws + W_F13), DM, DM, nullptr}; GridOrder S; S.init(MTOK / 256, 22, XPLACE());
      EpiSwiGLU E{R2, DFF, 22};
      pg8::gemm_phase<EpiSwiGLU, GridOrder, true, false>(lds, g, S, E); }
    GRID_BAR();
    PH(9) { pg8::Gemm g{R2, (const bf16_t*)(ws + W_F2), DFF, DFF, nullptr}; GridOrder S; S.init(MTOK / 256, 4, XPLACE());
      EpiPlain<0> E{R3, DM, nullptr, DM, 4};
      pg8::gemm_phase<EpiPlain<0>, GridOrder, true, false>(lds, g, S, E); }
    GRID_BAR();
    PH(10) phase_ln<true, true, false>(a.out, DN_ALPHA, R3, MOD0 + 5120, a.ln_g + 1024, a.ln_b + 1024, a.out, R1, MOD1 + 1024, MOD1, nullptr, nullptr, nullptr, nullptr, nullptr, opaque_tid());
    GRID_BAR();
    PH(11) { pg8::Gemm g{R1, (const bf16_t*)(ws + W_CIN), DM, DM, nullptr}; GridOrder S; S.init(MTOK / 256, 12, XPLACE());
      EpiConvIn E{R2, R2 + (size_t)MTOK * DM};
      pg8::gemm_phase<EpiConvIn, GridOrder, true, false>(lds, g, S, E); }
    GRID_BAR();
    PH(12) phase_conv(R2, R2 + (size_t)MTOK * DM, a.conv_taps, R3, opaque_tid());
    GRID_BAR();
    PH(13) { pg8::Gemm g{R3, (const bf16_t*)(ws + W_COUT), DM, DM, nullptr}; GridOrder S; S.init(MTOK / 256, 4, XPLACE());
      EpiPlain<0> E{R1, DM, nullptr, DM, 4};
      pg8::gemm_phase<EpiPlain<0>, GridOrder, true, false>(lds, g, S, E); }
    GRID_BAR();
    PH(14) phase_ln<true, true, true>(a.out, DN_ALPHA, R1, MOD1 + 2048, a.ln_g + 2048, a.ln_b + 2048, a.out, R3, MOD1 + 4096, MOD1 + 3072, a.router_w, a.router_b,
                               ctl + CW_ECNT, (int*)(ws + WS_ASG), (float*)(ws + WS_AGATE), opaque_tid());
    GRID_BAR();
    PH(15) phase_moe_rows(ws, opaque_tid());
    GRID_BAR();
    bf16_t* ACT = (bf16_t*)(ws + WS_R1);
#pragma unroll 1
    for (int k = 0; k < 2; ++k) {
        MoeOrder S; { const XcdPlace XP = XPLACE(); S.G = XP.G; S.base = XP.base; S.nloc = XP.nloc; S.r = XP.r; } S.tend = (const LAS unsigned*)(lds + MISC_OFF + 64);
        __syncthreads();
        if (tid0 < 8) ((LAS unsigned*)(lds + MISC_OFF + 64))[tid0] = xb_ld(ctl + CW_TEND + 8 * k + tid0);
        __syncthreads();
        S.ntiles = __builtin_amdgcn_readfirstlane((int)S.tend[7]);
        const int* rowtok = (const int*)(ws + WS_ROWTOK) + k * MOE_ROWS; const float* rowgate = (const float*)(ws + WS_ROWGATE) + k * MOE_ROWS;
        PH(16) { S.NJ = 22; pg8::Gemm g{R3, (const bf16_t*)(ws + W_E13), DM, DM, rowtok};
          EpiSwiGLU E{ACT, DFF, 22};
          pg8::gemm_phase<EpiSwiGLU, MoeOrder, true, true>(lds, g, S, E); }
        GRID_BAR();
        PH(17) { S.NJ = 4; pg8::Gemm g{ACT, (const bf16_t*)(ws + W_E2), DFF, DFF, nullptr};
          const bool real_ = (rep_ + 1 == (int)(((PHSEL >> 17) & 1u) + ((REPMASK >> 17) & 1u)));
          EpiMoeDown E{a.out, rowtok, rowgate, MOD1 + 5120, (real_ && k == 0) ? DN_ALPHA : 1.0f, real_ ? 1.0f : 0.0f}; pg8::gemm_phase<EpiMoeDown, MoeOrder, true, false>(lds, g, S, E); }
        GRID_BAR();
    }
    PH(18) phase_ln<false, false, false>(a.out, 1.0f, nullptr, nullptr, a.ln_g + 3072, a.ln_b + 3072, a.out, nullptr, nullptr, nullptr, nullptr, nullptr, nullptr, nullptr, nullptr, opaque_tid());
#undef GRID_BAR
}

extern "C" void kernel_launch(void* const* d_in, const int* in_sizes, int n_in, void* d_out, int out_size, void* d_ws, size_t ws_size, hipStream_t stream) {
    static int grid = 0;
    if (grid == 0) {
        if (n_in != 22 || in_sizes[0] != MTOK * DM || out_size != MTOK * DM || ws_size < WS_END) {
            fprintf(stderr, "kernel_launch: unexpected problem (n_in %d, in0 %d, out %d, ws %zu); nothing launched\n", n_in, n_in > 0 ? in_sizes[0] : -1, out_size, ws_size); grid = -1; return; }
        int dev = 0, cus = 0, per_cu = 0;
        if (hipGetDevice(&dev) != hipSuccess || hipDeviceGetAttribute(&cus, hipDeviceAttributeMultiprocessorCount, dev) != hipSuccess) { grid = -1; return; }
        if (hipFuncSetAttribute((const void*)hybrid_fwd, hipFuncAttributeMaxDynamicSharedMemorySize, LDS_BYTES) != hipSuccess) { fprintf(stderr, "kernel_launch: hipFuncSetAttribute failed\n"); grid = -1; return; }
        if (hipOccupancyMaxActiveBlocksPerMultiprocessor(&per_cu, (const void*)hybrid_fwd, 512, LDS_BYTES) != hipSuccess || per_cu < 1)
            fprintf(stderr, "kernel_launch: note: occupancy query reports %d workgroups per CU\n", per_cu);
        (void)hipGetLastError();
        grid = cus;
    }
    if (grid < 0) return;
    if (hipMemsetAsync((char*)d_ws + WS_CTL, 0, CTL_BYTES, stream) != hipSuccess) { fprintf(stderr, "kernel_launch: hipMemsetAsync failed\n"); return; }
    Args a{};
    a.x = (const float*)d_in[0]; a.c = (const float*)d_in[1]; a.ada_w = (const float*)d_in[2]; a.ada_b = (const float*)d_in[3]; a.ln_g = (const float*)d_in[4]; a.ln_b = (const float*)d_in[5];
    a.mix_w_in = (const float*)d_in[6]; a.cmp_pos = (const float*)d_in[7]; a.cmp_w1 = (const float*)d_in[8]; a.cmp_w2 = (const float*)d_in[9]; a.mix_w_out = (const float*)d_in[10];
    a.ffn_w1 = (const float*)d_in[11]; a.ffn_w3 = (const float*)d_in[12]; a.ffn_w2 = (const float*)d_in[13]; a.conv_w_in = (const float*)d_in[14]; a.conv_taps = (const float*)d_in[15];
    a.conv_w_out = (const float*)d_in[16]; a.router_w = (const float*)d_in[17]; a.router_b = (const float*)d_in[18]; a.exp_w1 = (const float*)d_in[19]; a.exp_w3 = (const float*)d_in[20];
    a.exp_w2 = (const float*)d_in[21];
    a.out = (float*)d_out; a.ws = (unsigned char*)d_ws;
    hipLaunchKernelGGL(hybrid_fwd, dim3(grid), dim3(512), LDS_BYTES, stream, a);
    const hipError_t le = hipPeekAtLastError();
    if (le != hipSuccess) fprintf(stderr, "kernel_launch: launch failed: %s\n", hipGetErrorName(le));
}
```

```cpp
#include <hip/hip_runtime.h>
#include <cstdio>
#include <cstdint>

#define LAS __attribute__((address_space(3)))
#define GAS __attribute__((address_space(1)))
typedef unsigned short bf16_t;
typedef short bf16x8 __attribute__((ext_vector_type(8)));
typedef short s16x4 __attribute__((ext_vector_type(4)));
typedef float f32x4 __attribute__((ext_vector_type(4)));
typedef float f32x2 __attribute__((ext_vector_type(2)));
typedef float f32x16 __attribute__((ext_vector_type(16)));
typedef unsigned u32x4 __attribute__((ext_vector_type(4)));
typedef unsigned u32x2 __attribute__((ext_vector_type(2)));

constexpr int BATCH = 16, SEQ = 2048, DM = 1024, MTOK = BATCH * SEQ;
constexpr int NPROJ = 2816;
constexpr int MIXN = 2840, MIXNP = 3072;
constexpr int DFF = 2816, NEXP = 8;
constexpr int MOE_ROWS = 34816;
constexpr float LN_EPS = 1e-5f;
constexpr float DN_ALPHA = 1.4142135623730951f;
constexpr float LOG2E = 1.4426950408889634f;
constexpr float QSCALE = 0.125f * LOG2E;

constexpr size_t MiB = 1u << 20;
constexpr size_t WS_CTL = 0, CTL_BYTES = 1 * MiB;
constexpr size_t WS_SMALL = 1 * MiB;
constexpr size_t WS_MOD = WS_SMALL;
constexpr size_t WS_CBIAS = WS_MOD + 786432;
constexpr size_t WS_ASG = WS_CBIAS + 4096;
constexpr size_t WS_AGATE = WS_ASG + 2 * MTOK * 4;
constexpr size_t WS_ROWTOK = WS_AGATE + 2 * MTOK * 4;
constexpr size_t WS_ROWGATE = WS_ROWTOK + 2 * MOE_ROWS * 4;
constexpr size_t WS_SMALL_END = WS_ROWGATE + 2 * MOE_ROWS * 4;
static_assert(WS_SMALL_END <= 8 * MiB, "small tables");
constexpr size_t WS_W = 8 * MiB;
constexpr size_t W_MIX = WS_W;
constexpr size_t W_OUT = W_MIX + (size_t)MIXNP * DM * 2;
constexpr size_t W_F13 = W_OUT + (size_t)DM * DM * 2;
constexpr size_t W_F2 = W_F13 + (size_t)2 * DFF * DM * 2;
constexpr size_t W_CIN = W_F2 + (size_t)DM * DFF * 2;
constexpr size_t W_COUT = W_CIN + (size_t)3 * DM * DM * 2;
constexpr size_t W_E13 = W_COUT + (size_t)DM * DM * 2;
constexpr size_t W_E2 = W_E13 + (size_t)NEXP * 2 * DFF * DM * 2;
constexpr size_t W_C1 = W_E2 + (size_t)NEXP * DM * DFF * 2;
constexpr size_t W_C2 = W_C1 + (size_t)2 * 256 * 2048 * 2;
constexpr size_t WS_W_END = W_C2 + (size_t)2 * 256 * 256 * 2;
constexpr size_t WS_R1 = 176 * MiB;
constexpr size_t WS_R2 = 240 * MiB;
constexpr size_t WS_R3 = 416 * MiB;
constexpr size_t WS_END = 480 * MiB;
static_assert(WS_W_END <= WS_R1, "weights fit");
static_assert((size_t)MOE_ROWS * DFF * 2 <= WS_R3 - WS_R1, "MoE activation chunk fits R1+R2");
constexpr size_t R2_Q = WS_R2;
constexpr size_t R2_SBK = WS_R2 + 64 * MiB;
constexpr size_t R2_SBV = WS_R2 + 96 * MiB;
constexpr size_t R2_NSA = WS_R2 + 128 * MiB;
constexpr size_t R3_KC = WS_R3;
constexpr size_t R3_KCPAD = R3_KC + 16 * MiB;
constexpr size_t R3_GATE = R3_KC + 17 * MiB;
constexpr size_t R3_HID = R3_KC + 21 * MiB;
constexpr size_t R3_KCV = R3_KC + 25 * MiB;

constexpr int CW_BAR = 4096;
constexpr int CW_WQ = 8192;
constexpr int CW_ECNT = 9216;
constexpr int CW_TEND = 12288;

constexpr int LDS_BYTES = 147456;
constexpr int MISC_OFF = 131072 + 320;

__device__ __forceinline__ unsigned cvt_pk_bf16(float lo, float hi) { unsigned r; asm volatile("v_cvt_pk_bf16_f32 %0, %1, %2" : "=v"(r) : "v"(lo), "v"(hi)); return r; }
__device__ __forceinline__ float bf2f(bf16_t v) { return __uint_as_float((unsigned)v << 16); }
__device__ __forceinline__ float bflo(unsigned w) { return __uint_as_float(w << 16); }
__device__ __forceinline__ float bfhi(unsigned w) { return __uint_as_float(w & 0xffff0000u); }
__device__ __forceinline__ float fast_exp2(float x) { return __builtin_amdgcn_exp2f(x); }
__device__ __forceinline__ float fast_log2(float x) { return __builtin_amdgcn_logf(x); }
__device__ __forceinline__ float fast_rcp(float x) { return __builtin_amdgcn_rcpf(x); }
__device__ __forceinline__ float silu_f(float a) { return a * fast_rcp(1.0f + fast_exp2(-a * LOG2E)); }
__device__ __forceinline__ float sigmoid_f(float a) { return fast_rcp(1.0f + fast_exp2(-a * LOG2E)); }
__device__ __forceinline__ float wave_sum(float v) {
#pragma unroll
    for (int o = 1; o < 64; o <<= 1) v += __shfl_xor(v, o);
    return v;
}

__device__ __forceinline__ int opaque_tid() { int t = threadIdx.x; asm volatile("" : "+v"(t)); return t; }

namespace pg8 {
constexpr int BM = 256, BK = 64, HALF = 128, HTB = HALF * BK * 2, STAGE_BYTES = 8 * HTB;
__host__ __device__ __forceinline__ int lds_byte(int r, int c) { const int st = (r >> 4) * 2 + (c >> 5), rr = r & 15, cc = c & 31, ob = rr * 64 + cc * 2; return st * 1024 + (ob ^ (((ob >> 9) & 1) << 5)); }
__host__ __device__ __forceinline__ void stage_rc(int b, int& R, int& C) { const int st = b / 1024, sb = b % 1024, swz = sb ^ (((sb >> 9) & 1) << 5); R = (st >> 1) * 16 + swz / 64; C = (st & 1) * 32 + (swz % 64) / 2; }
__host__ __device__ __forceinline__ int perm32(int rho) { const int n = rho >> 4, i = rho & 15; return 8 * (i >> 2) + 4 * n + (i & 3); }

struct Unit { int pm, pn; };
struct Gemm { const bf16_t* A; const bf16_t* Bt; int lda; int K; const int* rowidx; };

template <class Epi, class Sched, bool ALIGN_EPI, bool GATHER>
__device__ __forceinline__ void gemm_phase(LAS unsigned char* lds, const Gemm g, const Sched& S, const Epi& E) {
    const int tid = opaque_tid(), wid = __builtin_amdgcn_readfirstlane(tid >> 6), lane = tid & 63, wr = wid >> 2, wc = wid & 3, fr = lane & 15, fq = lane >> 4;
    const int K = g.K, nt = K / BK, lda = g.lda;
    unsigned vA[2][2], vAn[2][2], vB[2]; int rA[2], cA2[2];
#pragma unroll
    for (int i = 0; i < 2; ++i) { int R, C; stage_rc(tid * 16 + i * 8192, R, C); const int Rb = Epi::PERM ? ((R & ~31) + perm32(R & 31)) : R;
        rA[i] = R; cA2[i] = C * 2;
        vA[0][i] = (unsigned)(R * lda + C) * 2u; vA[1][i] = (unsigned)((R + HALF) * lda + C) * 2u; vB[i] = (unsigned)(Rb * K + C) * 2u;
        vAn[0][i] = vA[0][i]; vAn[1][i] = vA[1][i]; }
    const size_t kstep = (size_t)(BK * 2);
    const size_t hstepB = (size_t)HALF * K * 2;
    const size_t tstepB = 2 * hstepB;
    const size_t tstepA = (size_t)BM * lda * 2;
    const unsigned ldsw = (unsigned)wid * 1024u;
    const int aoff = lds_byte(wr * 64 + fr, fq * 8), boff = lds_byte(wc * 32 + fr, fq * 8);
#define PG8_SA(b, h) (((b) * 2 + (h)) * HTB)
#define PG8_SB(b, h) ((4 + (b) * 2 + (h)) * HTB)
#define PG8_STAGE2(bufoff, gbase, o0, o1) do { \
        __builtin_amdgcn_global_load_lds((const unsigned*)((const char*)(gbase) + (o0)), (LAS unsigned*)(lds + (bufoff) + ldsw), 16, 0, 0); \
        __builtin_amdgcn_global_load_lds((const unsigned*)((const char*)(gbase) + (o1)), (LAS unsigned*)(lds + (bufoff) + ldsw + 8192), 16, 0, 0); } while (0)
#define PG8_STB(bufoff, gbase) PG8_STAGE2(bufoff, gbase, vB[0], vB[1])
#define PG8_STA(bufoff, gbase, h) PG8_STAGE2(bufoff, gbase, vA[h][0], vA[h][1])
#define PG8_LDA(dst, b, h) do { _Pragma("unroll") for (int m = 0; m < 4; ++m) _Pragma("unroll") for (int k = 0; k < 2; ++k) dst[m][k] = *(const LAS bf16x8*)(lds + PG8_SA(b, h) + aoff + m * 2048 + k * 1024); } while (0)
#define PG8_LDB(dst, b, h) do { _Pragma("unroll") for (int n = 0; n < 2; ++n) _Pragma("unroll") for (int k = 0; k < 2; ++k) dst[n][k] = *(const LAS bf16x8*)(lds + PG8_SB(b, h) + boff + n * 2048 + k * 1024); } while (0)
#define PG8_MMA(ai, bj, At, Bt) do { __builtin_amdgcn_s_setprio(1); _Pragma("unroll") for (int m = 0; m < 4; ++m) _Pragma("unroll") for (int n = 0; n < 2; ++n) _Pragma("unroll") for (int k = 0; k < 2; ++k) \
        acc[ai][bj][m][n] = __builtin_amdgcn_mfma_f32_16x16x32_bf16(Bt[n][k], At[m][k], acc[ai][bj][m][n], 0, 0, 0); __builtin_amdgcn_s_setprio(0); } while (0)
#define PG8_WAIT_V(n) asm volatile("s_waitcnt vmcnt(" #n ")" ::: "memory")
#define PG8_WAIT_L(n) asm volatile("s_waitcnt lgkmcnt(" #n ")" ::: "memory")
#define PG8_BAR __builtin_amdgcn_s_barrier()
#define PG8_SCHED __builtin_amdgcn_sched_barrier(0)
#define PG8_GIDX(dst, u) do { if constexpr (GATHER) { _Pragma("unroll") for (int h = 0; h < 2; ++h) _Pragma("unroll") for (int i = 0; i < 2; ++i) { \
        int tk = g.rowidx[(u).pm * BM + h * HALF + rA[i]]; tk = tk < 0 ? 0 : tk; dst[h][i] = (unsigned)tk * (unsigned)(lda * 2) + (unsigned)cA2[i]; } } } while (0)
    Unit cur, nxt; int ui = 0;
    if (!S.next(0, cur)) return;
    f32x4 acc[2][2][4][2];
#pragma unroll
    for (int a = 0; a < 2; ++a)
#pragma unroll
        for (int b = 0; b < 2; ++b)
#pragma unroll
            for (int m = 0; m < 4; ++m)
#pragma unroll
                for (int n = 0; n < 2; ++n) acc[a][b][m][n] = (f32x4){0.f, 0.f, 0.f, 0.f};
    bf16x8 At[4][2], B0[2][2], B1[2][2];
    const char* cA = GATHER ? (const char*)g.A : (const char*)g.A + (size_t)cur.pm * tstepA; const char* cB = (const char*)g.Bt + (size_t)cur.pn * tstepB;
    PG8_GIDX(vA, cur);
    PG8_STB(PG8_SB(0, 0), cB); PG8_STB(PG8_SB(0, 1), cB + hstepB); PG8_STA(PG8_SA(0, 0), cA, 0); PG8_STA(PG8_SA(0, 1), cA, 1);
    if (wr == 1) PG8_BAR;
    PG8_WAIT_V(2); PG8_BAR;
    PG8_STB(PG8_SB(1, 0), cB + kstep); PG8_STA(PG8_SA(1, 0), cA + kstep, 0); PG8_STB(PG8_SB(1, 1), cB + hstepB + kstep);
    PG8_WAIT_V(6); PG8_BAR;
    for (;;) {
        const bool has_next = S.next(ui + 1, nxt);
        const char* nA = GATHER ? cA : (has_next ? (const char*)g.A + (size_t)nxt.pm * tstepA : cA); const char* nB = has_next ? (const char*)g.Bt + (size_t)nxt.pn * tstepB : cB;
        if constexpr (GATHER) { if (has_next) { PG8_GIDX(vAn, nxt); } else {
#pragma unroll
            for (int h = 0; h < 2; ++h)
#pragma unroll
                for (int i = 0; i < 2; ++i) vAn[h][i] = vA[h][i]; } }
        for (int t = 0; t < nt; t += 2) {
            const bool last = (t == nt - 2);
            const char* a1 = cA + (size_t)(t + 1) * kstep;
            const char* a2 = last ? nA : cA + (size_t)(t + 2) * kstep; const char* b2 = last ? nB : cB + (size_t)(t + 2) * kstep;
            const char* a3 = a2 + kstep; const char* b3 = b2 + kstep;
            PG8_LDB(B0, 0, 0); PG8_LDB(B1, 0, 1); PG8_SCHED; PG8_LDA(At, 0, 0); PG8_STA(PG8_SA(1, 1), a1, 1);
            if constexpr (GATHER) { if (last) {
#pragma unroll
                for (int h = 0; h < 2; ++h)
#pragma unroll
                    for (int i = 0; i < 2; ++i) vA[h][i] = vAn[h][i]; } }
            PG8_WAIT_V(8); PG8_WAIT_L(0); PG8_BAR; PG8_MMA(0, 0, At, B0); PG8_MMA(0, 1, At, B1); PG8_BAR; PG8_SCHED;
            PG8_LDA(At, 0, 1); PG8_STB(PG8_SB(0, 0), b2); PG8_STB(PG8_SB(0, 1), b2 + hstepB); PG8_STA(PG8_SA(0, 0), a2, 0);
            PG8_WAIT_V(8); PG8_WAIT_L(0); PG8_BAR; PG8_MMA(1, 0, At, B0); PG8_MMA(1, 1, At, B1); PG8_BAR; PG8_SCHED;
            PG8_LDB(B0, 1, 0); PG8_LDB(B1, 1, 1); PG8_SCHED; PG8_LDA(At, 1, 0); PG8_STA(PG8_SA(0, 1), a2, 1);
            PG8_WAIT_V(8); PG8_WAIT_L(0); PG8_BAR; PG8_MMA(0, 0, At, B0); PG8_MMA(0, 1, At, B1); PG8_BAR; PG8_SCHED;
            PG8_LDA(At, 1, 1); PG8_STB(PG8_SB(1, 0), b3); PG8_STB(PG8_SB(1, 1), b3 + hstepB); PG8_STA(PG8_SA(1, 0), a3, 0);
            PG8_WAIT_V(8); PG8_WAIT_L(0); PG8_BAR; PG8_MMA(1, 0, At, B0); PG8_MMA(1, 1, At, B1); PG8_BAR; PG8_SCHED;
        }
        if constexpr (ALIGN_EPI) { if (wr == 0) PG8_BAR; }
        E(acc, cur, wr, wc, fr, fq);
        if (!has_next) break;
#pragma unroll
        for (int a = 0; a < 2; ++a)
#pragma unroll
            for (int b = 0; b < 2; ++b)
#pragma unroll
                for (int m = 0; m < 4; ++m)
#pragma unroll
                    for (int n = 0; n < 2; ++n) acc[a][b][m][n] = (f32x4){0.f, 0.f, 0.f, 0.f};
        cur = nxt; cA = nA; cB = nB; ++ui;
        if constexpr (ALIGN_EPI) { if (wr == 1) PG8_BAR; }
    }
    PG8_WAIT_V(0);
    if constexpr (!ALIGN_EPI) { if (wr == 0) PG8_BAR; }
    PG8_BAR;
#undef PG8_SA
#undef PG8_SB
#undef PG8_STAGE2
#undef PG8_STB
#undef PG8_STA
#undef PG8_LDA
#undef PG8_LDB
#undef PG8_MMA
#undef PG8_WAIT_V
#undef PG8_WAIT_L
#undef PG8_BAR
#undef PG8_SCHED
#undef PG8_GIDX
}
}

#define XB_TMO      128
#define XB_XCNT(j)  (256  + 64 * (j))
#define XB_XSUB(j)  (1280 + 64 * (j))
#define XB_XGEN(j)  (2304 + 64 * (j))
#define XB_TOP      3328
#define XB_TOPGEN   3392
#define XCD_BAR_WORDS 3456
#define XB_SPIN_CAP (1u << 18)
__device__ __forceinline__ unsigned xb_ld(unsigned* p)              { return __hip_atomic_load(p, __ATOMIC_RELAXED, __HIP_MEMORY_SCOPE_AGENT); }
__device__ __forceinline__ unsigned xb_add(unsigned* p, unsigned v) { return __hip_atomic_fetch_add(p, v, __ATOMIC_RELAXED, __HIP_MEMORY_SCOPE_AGENT); }
__device__ __forceinline__ unsigned xb_xcc_id() { return (unsigned)__builtin_amdgcn_s_getreg((3 << 11) | 20) & 0xFu; }
#define XB_SPIN(cond, bar) do { unsigned _sp = 0; while (cond) { __builtin_amdgcn_s_sleep(1); \
    if ((++_sp & 255u) == 0u) { if (xb_ld(&(bar)[XB_TMO])) break; if (_sp > XB_SPIN_CAP) { atomicAdd(&(bar)[XB_TMO], 1u); break; } } } } while (0)
struct XcdBarrier { unsigned* bar; unsigned x; volatile LAS unsigned* st; };
__device__ __forceinline__ XcdBarrier xcd_barrier_post(unsigned* bar, volatile LAS unsigned* st) {
    XcdBarrier b; b.bar = bar; b.x = xb_xcc_id(); b.st = st;
    if (threadIdx.x == 0) (void)xb_add(&bar[XB_XCNT(b.x)], 1u);
    return b;
}
__device__ __forceinline__ void xcd_barrier_complete(unsigned* bar, unsigned x, unsigned& nloc, unsigned& nx) {
    const unsigned G = gridDim.x * gridDim.y * gridDim.z;
    unsigned sum, cnt, mine, sp = 0u;
    for (;;) {
        sum = 0u; cnt = 0u; mine = 0u;
#pragma unroll
        for (unsigned j = 0; j < 16; ++j) { const unsigned c = xb_ld(&bar[XB_XCNT(j)]); sum += c; cnt += (c > 0u) ? 1u : 0u; mine = (j == x) ? c : mine; }
        if (sum == G) break;
        __builtin_amdgcn_s_sleep(1);
        if ((++sp & 255u) == 0u) { if (xb_ld(&bar[XB_TMO])) break; if (sp > XB_SPIN_CAP) { atomicAdd(&bar[XB_TMO], 1u); break; } }
    }
    nloc = mine > 0u ? mine : 1u; nx = cnt > 0u ? cnt : 1u;
}
__device__ __forceinline__ void xcd_barrier(const XcdBarrier& b) {
    asm volatile("s_waitcnt vmcnt(0)" ::: "memory");
    __syncthreads();
    if (threadIdx.x == 0) {
        unsigned* bar = b.bar;
        __builtin_amdgcn_s_waitcnt(0);
        unsigned nloc = b.st[0], nx = b.st[1];
        if (nloc == 0u) { xcd_barrier_complete(bar, b.x, nloc, nx); b.st[0] = nloc; b.st[1] = nx; }
        const unsigned old = xb_add(&bar[XB_XSUB(b.x)], 1u);
        const unsigned gen = old / nloc;
        if (old + 1u == (gen + 1u) * nloc) {
            __builtin_amdgcn_fence(__ATOMIC_RELEASE, "agent");
            asm volatile("s_waitcnt vmcnt(0)" ::: "memory");
            const unsigned og = xb_add(&bar[XB_TOP], 1u);
            const unsigned tg = og / nx;
            if (og + 1u == (tg + 1u) * nx) xb_add(&bar[XB_TOPGEN], 1u);
            else XB_SPIN(xb_ld(&bar[XB_TOPGEN]) == tg, bar);
            __builtin_amdgcn_fence(__ATOMIC_ACQUIRE, "agent");
            xb_add(&bar[XB_XGEN(b.x)], 1u);
            asm volatile("s_waitcnt vmcnt(0)" ::: "memory");
        } else {
            XB_SPIN(xb_ld(&bar[XB_XGEN(b.x)]) == gen, bar);
            __builtin_amdgcn_fence(__ATOMIC_ACQUIRE, "agent");
            asm volatile("s_waitcnt vmcnt(0)" ::: "memory");
        }
    }
    __syncthreads();
}

struct GridOrder {
    int nM, nN, nwg, G, c;
    __device__ __forceinline__ void init(int nM_, int nN_, int G_, int c_) { nM = nM_; nN = nN_; nwg = nM_ * nN_; G = G_; c = c_; }
    __device__ __forceinline__ bool next(int i, pg8::Unit& u) const {
        int L = i * G + c; if (L >= nwg) return false;
        const int nig = 8 * nN, gid = L / nig, fm = gid * 8, gsz = (nM - fm) < 8 ? (nM - fm) : 8, w = L % nig;
        u.pm = fm + (w % gsz); u.pn = w / gsz; return true;
    }
};
struct CmpOrder {
    int G, c;
    __device__ __forceinline__ bool next(int i, pg8::Unit& u) const { const int L = i * G + c; if (L >= 32) return false; u.pm = L; u.pn = L >> 4; return true; }
};
struct MoeOrder {
    int G, c, NJ, lo, ntiles, dh, early; const LAS unsigned* tend;
    __device__ __forceinline__ bool next(int i, pg8::Unit& u) const {
        int L; if (c < dh) L = early * (G - dh) + i * G + c; else L = (i < early) ? i * (G - dh) + (c - dh) : early * (G - dh) + (i - early) * G + c;
        const int nwg = ntiles * NJ; if (L >= nwg) return false;
        const int nig = 8 * NJ, gid = L / nig, fm = gid * 8, gsz = (ntiles - fm) < 8 ? (ntiles - fm) : 8, w = L % nig;
        const int rt = lo + fm + (w % gsz), j = w / gsz; int e = 0;
#pragma unroll
        for (int q = 0; q < 7; ++q) e += (rt >= (int)tend[q]) ? 1 : 0;
        u.pm = rt; u.pn = __builtin_amdgcn_readfirstlane(e) * NJ + j; return true;
    }
};

typedef const f32x4 (&AccRef)[2][2][4][2];
__device__ __forceinline__ u32x4 pack8(f32x4 a, f32x4 b) { u32x4 w; w.x = cvt_pk_bf16(a[0], a[1]); w.y = cvt_pk_bf16(a[2], a[3]); w.z = cvt_pk_bf16(b[0], b[1]); w.w = cvt_pk_bf16(b[2], b[3]); return w; }

template <int ACT> struct EpiPlain {
    static constexpr bool PERM = true;
    bf16_t* O; int ldc; const float* bias; int ncols_valid; int pn_mod;
    __device__ __forceinline__ void operator()(AccRef acc, const pg8::Unit& u, int wr, int wc, int fr, int fq) const {
        const int row0 = u.pm * 256 + wr * 64 + fr; const int colt = (u.pn % pn_mod) * 256;
#pragma unroll
        for (int bj = 0; bj < 2; ++bj) { const int col = colt + bj * 128 + wc * 32 + 8 * fq; if (col >= ncols_valid) continue;
            f32x4 b0 = (f32x4){0.f, 0.f, 0.f, 0.f}, b1 = b0;
            if (ACT == 1) { const float* bp = bias + u.pn * 256 + bj * 128 + wc * 32 + 8 * fq; b0 = *(const f32x4*)bp; b1 = *(const f32x4*)(bp + 4); }
#pragma unroll
            for (int ai = 0; ai < 2; ++ai)
#pragma unroll
                for (int m = 0; m < 4; ++m) { f32x4 v0 = acc[ai][bj][m][0], v1 = acc[ai][bj][m][1];
                    if (ACT == 1) { v0 += b0; v1 += b1;
#pragma unroll
                        for (int e = 0; e < 4; ++e) { v0[e] = silu_f(v0[e]); v1[e] = silu_f(v1[e]); } }
                    *(u32x4*)(O + (size_t)(row0 + ai * 128 + m * 16) * ldc + col) = pack8(v0, v1); } }
    }
};
struct EpiMix {
    static constexpr bool PERM = true;
    bf16_t* Q; unsigned char* SBK; unsigned char* SBV; unsigned char* NSAI; bf16_t* KC; float* GATE;
    __device__ __forceinline__ void operator()(AccRef acc, const pg8::Unit& u, int wr, int wc, int fr, int fq) const {
        const int row = u.pm * 256 + wr * 64 + fr; const int pn = u.pn;
        const int b = row >> 11, t = row & 2047, tile = t >> 6, key = t & 63;
        const float sc = (pn < 2 || pn == 6 || pn == 7) ? QSCALE : 1.0f;
#pragma unroll
        for (int bj = 0; bj < 2; ++bj) { const int cc = bj * 128 + wc * 32 + 8 * fq;
            unsigned char* base; int sm, sa = 16384; bool gate = false, skip = false;
            if (pn == 11) { gate = true; skip = cc >= 24; base = (unsigned char*)(GATE + (size_t)row * 32 + cc); sm = 2048; }
            else if (pn == 8) { const int which = cc >> 7, g = (cc >> 6) & 1, d = cc & 63; base = (unsigned char*)(KC + ((((size_t)(which * 16 + b) * 2 + g) * 2048 + t) * 64 + d)); sm = 2048; }
            else if (pn < 2 || pn == 6 || pn == 7) { const int col = (pn < 2 ? pn * 256 : 512 + (pn - 6) * 256) + cc; base = (unsigned char*)(Q + (size_t)row * DM + col); sm = 32768; sa = 262144; }
            else if (pn < 6) { const int ci = (pn & 1) * 256 + cc, h = ci >> 6, d0 = ci & 63; const size_t img = ((size_t)((b * 8 + h) * 32 + tile)) * 8192;
                if (pn < 4) { base = SBK + img + (d0 >> 3) * 1024 + key * 16; sm = 256; } else { base = SBV + img + (d0 >> 5) * 4096 + key * 64 + (d0 & 31) * 2; sm = 1024; } }
            else { const int isv = cc >> 7, g = (cc >> 6) & 1, d0 = cc & 63, wimg = (pn - 9) * 2 + isv; const size_t img = ((size_t)(((wimg * 16 + b) * 2 + g) * 32 + tile)) * 8192;
                if (!isv) { base = NSAI + img + (d0 >> 3) * 1024 + key * 16; sm = 256; } else { base = NSAI + img + (d0 >> 5) * 4096 + key * 64 + (d0 & 31) * 2; sm = 1024; } }
            if (skip) continue;
#pragma unroll
            for (int ai = 0; ai < 2; ++ai)
#pragma unroll
                for (int m = 0; m < 4; ++m) { f32x4 v0 = acc[ai][bj][m][0] * sc, v1 = acc[ai][bj][m][1] * sc; unsigned char* dp = base + m * sm + ai * sa;
                    if (gate) {
#pragma unroll
                        for (int e = 0; e < 4; ++e) { v0[e] = sigmoid_f(v0[e]); v1[e] = sigmoid_f(v1[e]); }
                        *(f32x4*)dp = v0; *(f32x4*)(dp + 16) = v1; }
                    else *(u32x4*)dp = pack8(v0, v1); } }
    }
};
struct EpiSwiGLU {
    static constexpr bool PERM = true;
    bf16_t* O; int ldc; int NJ;
    __device__ __forceinline__ void operator()(AccRef acc, const pg8::Unit& u, int wr, int wc, int fr, int fq) const {
        const int row0 = u.pm * 256 + wr * 64 + fr; const int col = (u.pn % NJ) * 128 + wc * 32 + 8 * fq;
#pragma unroll
        for (int ai = 0; ai < 2; ++ai)
#pragma unroll
            for (int m = 0; m < 4; ++m) { f32x4 v0, v1;
#pragma unroll
                for (int e = 0; e < 4; ++e) { v0[e] = silu_f(acc[ai][0][m][0][e]) * acc[ai][1][m][0][e]; v1[e] = silu_f(acc[ai][0][m][1][e]) * acc[ai][1][m][1][e]; }
                *(u32x4*)(O + (size_t)(row0 + ai * 128 + m * 16) * ldc + col) = pack8(v0, v1); }
    }
};
struct EpiConvIn {
    static constexpr bool PERM = true;
    bf16_t* Z; bf16_t* GB;
    __device__ __forceinline__ void operator()(AccRef acc, const pg8::Unit& u, int wr, int wc, int fr, int fq) const {
        const int row0 = u.pm * 256 + wr * 64 + fr;
        if (u.pn < 8) { const int col = u.pn * 128 + wc * 32 + 8 * fq;
#pragma unroll
            for (int ai = 0; ai < 2; ++ai)
#pragma unroll
                for (int m = 0; m < 4; ++m) *(u32x4*)(Z + (size_t)(row0 + ai * 128 + m * 16) * DM + col) = pack8(acc[ai][0][m][0] * acc[ai][1][m][0], acc[ai][0][m][1] * acc[ai][1][m][1]);
        } else {
#pragma unroll
            for (int bj = 0; bj < 2; ++bj) { const int col = (u.pn - 8) * 256 + bj * 128 + wc * 32 + 8 * fq;
#pragma unroll
                for (int ai = 0; ai < 2; ++ai)
#pragma unroll
                    for (int m = 0; m < 4; ++m) *(u32x4*)(GB + (size_t)(row0 + ai * 128 + m * 16) * DM + col) = pack8(acc[ai][bj][m][0], acc[ai][bj][m][1]); }
        }
    }
};
struct EpiMoeDown {
    static constexpr bool PERM = false;
    float* out; const int* rowtok; const float* rowgate; const float* g2; float first_scale; float amul;
    __device__ __forceinline__ void operator()(AccRef acc, const pg8::Unit& u, int wr, int wc, int fr, int fq) const {
        const int row0 = u.pm * 256 + wr * 64 + fr; const int colt = (u.pn & 3) * 256 + wc * 32 + 4 * fq;
#pragma unroll
        for (int ai = 0; ai < 2; ++ai)
#pragma unroll
            for (int m = 0; m < 4; ++m) { const int row = row0 + ai * 128 + m * 16; const int tok = rowtok[row]; if (tok < 0) continue;
                const float gt = rowgate[row]; const float* gp = g2 + (size_t)(tok >> 11) * 6144; float* op = out + (size_t)tok * DM;
#pragma unroll
                for (int bj = 0; bj < 2; ++bj)
#pragma unroll
                    for (int n = 0; n < 2; ++n) { const int col = colt + bj * 128 + n * 16; const f32x4 gg = *(const f32x4*)(gp + col); f32x4 o = *(f32x4*)(op + col);
                        o = o * first_scale;
                        o += (gg + 1.0f) * (gt * amul) * acc[ai][bj][m][n]; *(f32x4*)(op + col) = o; } }
    }
};

struct Args {
    const float *x, *c, *ada_w, *ada_b, *ln_g, *ln_b, *mix_w_in, *cmp_pos, *cmp_w1, *cmp_w2, *mix_w_out, *ffn_w1, *ffn_w3, *ffn_w2,
                *conv_w_in, *conv_taps, *conv_w_out, *router_w, *router_b, *exp_w1, *exp_w3, *exp_w2;
    float* out; unsigned char* ws;
};

__device__ __forceinline__ void transpose_item(const float* W, int N, int k0, int n0, bf16_t* WT, int dK, int drow0, LAS float* scr, int lane) {
    const int n = n0 + (lane & 31); const bool ok = n < N;
    float tv[32];
#pragma unroll
    for (int i = 0; i < 32; ++i) { const int kk = 2 * i + (lane >> 5); tv[i] = ok ? W[(size_t)(k0 + kk) * N + n] : 0.f; }
#pragma unroll
    for (int i = 0; i < 32; ++i) { const int kk = 2 * i + (lane >> 5); scr[kk * 33 + (lane & 31)] = tv[i]; }
    asm volatile("s_waitcnt lgkmcnt(0)" ::: "memory");
    const int c = lane & 7;
#pragma unroll
    for (int j = 0; j < 4; ++j) { const int nn = (lane >> 3) + 8 * j; const LAS float* s = scr + (8 * c) * 33 + nn;
        u32x4 o; o.x = cvt_pk_bf16(s[0 * 33], s[1 * 33]); o.y = cvt_pk_bf16(s[2 * 33], s[3 * 33]); o.z = cvt_pk_bf16(s[4 * 33], s[5 * 33]); o.w = cvt_pk_bf16(s[6 * 33], s[7 * 33]);
        *(u32x4*)(WT + (size_t)(drow0 + nn) * dK + k0 + 8 * c) = o; }
    asm volatile("s_waitcnt lgkmcnt(0)" ::: "memory");
}
__device__ __forceinline__ int il1(int n) { return (n >> 7) * 256 + (n & 127); }
__device__ __forceinline__ void weight_item(const Args& a, int it, LAS float* scr, int lane) {
    unsigned char* ws = a.ws;
#define WITEM(cnt, SRC, KK, NN, NBLK, DST, MODE, ROFF) if (it < (cnt)) { const int bi_ = it >> 3, kb = bi_ % ((KK) / 64), nb = (bi_ / ((KK) / 64)) * 8 + (it & 7), n0 = nb * 32; int dr; \
        if ((MODE) == 0) dr = n0; else if ((MODE) == 1) dr = il1(n0); else if ((MODE) == 2) dr = il1(n0) + 128; \
        else dr = (n0 < 1024) ? 2048 + n0 : ((n0 < 2048) ? il1(n0 - 1024) : il1(n0 - 2048) + 128); \
        transpose_item((SRC), (NN), kb * 64, n0, (bf16_t*)(DST), (KK), dr + (ROFF), scr, lane); return; } it -= (cnt);
    WITEM(1536, a.mix_w_in, 1024, MIXN, 96, ws + W_MIX, 0, 0)
    WITEM(512, a.mix_w_out, 1024, 1024, 32, ws + W_OUT, 0, 0)
    WITEM(1408, a.ffn_w1, 1024, DFF, 88, ws + W_F13, 1, 0)
    WITEM(1408, a.ffn_w3, 1024, DFF, 88, ws + W_F13, 2, 0)
    WITEM(1408, a.ffn_w2, DFF, 1024, 32, ws + W_F2, 0, 0)
    WITEM(1536, a.conv_w_in, 1024, 3072, 96, ws + W_CIN, 3, 0)
    WITEM(512, a.conv_w_out, 1024, 1024, 32, ws + W_COUT, 0, 0)
    { const int e = it / 1408; if (e < 8) { int it2 = it % 1408; const int bi_ = it2 >> 3, kb = bi_ % 16, nb = (bi_ / 16) * 8 + (it2 & 7), n0 = nb * 32;
        transpose_item(a.exp_w1 + (size_t)e * 1024 * DFF, DFF, kb * 64, n0, (bf16_t*)(ws + W_E13), 1024, il1(n0) + e * 2 * DFF, scr, lane); return; } it -= 8 * 1408; }
    { const int e = it / 1408; if (e < 8) { int it2 = it % 1408; const int bi_ = it2 >> 3, kb = bi_ % 16, nb = (bi_ / 16) * 8 + (it2 & 7), n0 = nb * 32;
        transpose_item(a.exp_w3 + (size_t)e * 1024 * DFF, DFF, kb * 64, n0, (bf16_t*)(ws + W_E13), 1024, il1(n0) + 128 + e * 2 * DFF, scr, lane); return; } it -= 8 * 1408; }
    { const int e = it / 1408; if (e < 8) { int it2 = it % 1408; const int bi_ = it2 >> 3, kb = bi_ % 44, nb = (bi_ / 44) * 8 + (it2 & 7), n0 = nb * 32;
        transpose_item(a.exp_w2 + (size_t)e * DFF * 1024, 1024, kb * 64, n0, (bf16_t*)(ws + W_E2), DFF, n0 + e * 1024, scr, lane); return; } it -= 8 * 1408; }
    { const int w = it / 256; if (w < 2) { int it2 = it % 256; const int kb = it2 >> 3, nb = it2 & 7, n0 = nb * 32;
        transpose_item(a.cmp_w1 + (size_t)w * 2048 * 256, 256, kb * 64, n0, (bf16_t*)(ws + W_C1), 2048, n0 + w * 256, scr, lane); return; } it -= 512; }
    { const int w = it / 32; if (w < 2) { int it2 = it % 32; const int kb = it2 >> 3, nb = it2 & 7, n0 = nb * 32;
        transpose_item(a.cmp_w2 + (size_t)w * 256 * 64, 64, kb * 64, n0, (bf16_t*)(ws + W_C2), 256, n0 + w * 256, scr, lane); return; } }
#undef WITEM
}
constexpr int N_WITEMS = 1536 + 512 + 1408 * 3 + 1536 + 512 + 3 * 8 * 1408 + 512 + 64;

template <int NB>
__device__ __forceinline__ void gemv_block(LAS float* sv, LAS float* part, const float* W, int K, int N, int j0, const float* bias, float* out, int out_pitch, int tid) {
    const int wid = tid >> 6, lane = tid & 63, kc = K / 8, kb = wid * kc;
    float acc[NB];
#pragma unroll
    for (int b = 0; b < NB; ++b) acc[b] = 0.f;
    const float* wp = W + (size_t)kb * N + j0 + lane;
    for (int k0 = 0; k0 < kc; k0 += 16) {
        float wv[16];
#pragma unroll
        for (int j = 0; j < 16; ++j) wv[j] = wp[(size_t)(k0 + j) * N];
#pragma unroll
        for (int j = 0; j < 16; ++j)
#pragma unroll
            for (int b = 0; b < NB; ++b) acc[b] += sv[b * K + kb + k0 + j] * wv[j]; }
#pragma unroll
    for (int b = 0; b < NB; ++b) part[(wid * NB + b) * 64 + lane] = acc[b];
    __syncthreads();
    for (int idx = tid; idx < NB * 64; idx += 512) { const int b = idx >> 6, l = idx & 63; float s = 0.f;
#pragma unroll
        for (int w = 0; w < 8; ++w) s += part[(w * NB + b) * 64 + l];
        if (bias) s += bias[j0 + l];
        out[(size_t)b * out_pitch + j0 + l] = s; }
    __syncthreads();
}

__device__ __forceinline__ void phase_prologue(const Args& a, LAS unsigned char* lds, int tid) {
    const int wid = tid >> 6, lane = tid & 63, G = gridDim.x, bx = blockIdx.x;
    LAS float* sv = (LAS float*)lds;
    LAS float* part = (LAS float*)(lds + 65536);
    float* MOD = (float*)(a.ws + WS_MOD); float* CB = (float*)(a.ws + WS_CBIAS);
    bool have_silu = false;
    __syncthreads();
    for (int item = bx; item < 200; item += G) {
        if (item < 192) {
            if (!have_silu) { for (int i = tid; i < 16 * 1024; i += 512) sv[i] = silu_f(a.c[i]); __syncthreads(); have_silu = true; }
            const int li = item / 96, jg = item % 96;
            gemv_block<16>(sv, part, a.ada_w + (size_t)li * 1024 * 6144, 1024, 6144, jg * 64, a.ada_b + li * 6144, MOD + (size_t)li * 16 * 6144, 6144, tid);
        } else {
            const int q = item - 192, w = q >> 2, jg = q & 3;
            __syncthreads();
            for (int i = tid; i < 2048; i += 512) sv[i] = a.cmp_pos[w * 2048 + i];
            __syncthreads(); have_silu = false;
            gemv_block<1>(sv, part, a.cmp_w1 + (size_t)w * 2048 * 256, 2048, 256, jg * 64, nullptr, CB + w * 256, 256, tid);
        }
    }
    __syncthreads();
    if (bx == G - 1) for (int i = tid; i < 65536 / 16; i += 512) *(u32x4*)(a.ws + R3_KCPAD + (size_t)i * 16) = (u32x4){0u, 0u, 0u, 0u};
    LAS float* scr = (LAS float*)(lds + wid * 16384);
    { constexpr int NBI = N_WITEMS / 8; unsigned* head = (unsigned*)(a.ws + WS_CTL) + CW_WQ + 256; volatile LAS unsigned* wqw = (volatile LAS unsigned*)(lds + MISC_OFF + 128);
      for (;;) { __syncthreads(); if (tid == 0) *wqw = atomicAdd(head, 1u); __syncthreads(); const int bi = (int)*wqw; if (bi >= NBI) break;
          weight_item(a, bi * 8 + wid, scr, lane); } }
}

__device__ __forceinline__ void phase_modulate(const float* x, const float* sc, const float* sh, bf16_t* h, int tid) {
    const int wid = tid >> 6, lane = tid & 63;
    for (int row = blockIdx.x * 8 + wid; row < MTOK; row += gridDim.x * 8) { const int b = row >> 11;
#pragma unroll
        for (int j = 0; j < 4; ++j) { const int c = 4 * lane + 256 * j; const f32x4 v = *(const f32x4*)(x + (size_t)row * DM + c);
            const f32x4 s = *(const f32x4*)(sc + b * 6144 + c), t = *(const f32x4*)(sh + b * 6144 + c); const f32x4 o = v * (s + 1.0f) + t;
            u32x2 w; w.x = cvt_pk_bf16(o[0], o[1]); w.y = cvt_pk_bf16(o[2], o[3]); *(u32x2*)(h + (size_t)row * DM + c) = w; } }
}
template <bool HAS_Y, bool HAS_H, bool ROUTER>
__device__ __forceinline__ void phase_ln(const float* xin, float xscale, const bf16_t* y, const float* gate, const float* lg, const float* lb, float* xout,
                                         bf16_t* hout, const float* sc, const float* sh, const float* rw, const float* rb, unsigned* ecnt, int* asg, float* agate, int tid) {
    const int wid = tid >> 6, lane = tid & 63;
    for (int row = blockIdx.x * 8 + wid; row < MTOK; row += gridDim.x * 8) { const int b = row >> 11;
        f32x4 v[4]; float s = 0.f;
#pragma unroll
        for (int j = 0; j < 4; ++j) { const int c = 4 * lane + 256 * j; v[j] = *(const f32x4*)(xin + (size_t)row * DM + c) * xscale;
            if (HAS_Y) { const u32x2 yw = *(const u32x2*)(y + (size_t)row * DM + c); const f32x4 gg = *(const f32x4*)(gate + b * 6144 + c);
                const f32x4 yv = (f32x4){bflo(yw.x), bfhi(yw.x), bflo(yw.y), bfhi(yw.y)}; v[j] += (gg + 1.0f) * yv; }
            s += (v[j][0] + v[j][1]) + (v[j][2] + v[j][3]); }
        const float mean = wave_sum(s) * (1.0f / DM); float s2 = 0.f;
#pragma unroll
        for (int j = 0; j < 4; ++j) { v[j] = v[j] - mean; s2 += (v[j][0] * v[j][0] + v[j][1] * v[j][1]) + (v[j][2] * v[j][2] + v[j][3] * v[j][3]); }
        const float rstd = 1.0f / sqrtf(wave_sum(s2) * (1.0f / DM) + LN_EPS);
        float lgt[8];
#pragma unroll
        for (int e = 0; e < 8; ++e) lgt[e] = 0.f;
#pragma unroll
        for (int j = 0; j < 4; ++j) { const int c = 4 * lane + 256 * j; const f32x4 g4 = *(const f32x4*)(lg + c), b4 = *(const f32x4*)(lb + c);
            const f32x4 xo = v[j] * rstd * g4 + b4; *(f32x4*)(xout + (size_t)row * DM + c) = xo;
            if (HAS_H) { const f32x4 s4 = *(const f32x4*)(sc + b * 6144 + c), t4 = *(const f32x4*)(sh + b * 6144 + c); const f32x4 hv = xo * (s4 + 1.0f) + t4;
                u32x2 w; w.x = cvt_pk_bf16(hv[0], hv[1]); w.y = cvt_pk_bf16(hv[2], hv[3]); *(u32x2*)(hout + (size_t)row * DM + c) = w;
                if (ROUTER) {
#pragma unroll
                    for (int q = 0; q < 4; ++q) { const f32x4 r0 = *(const f32x4*)(rw + (size_t)(c + q) * 8), r1 = *(const f32x4*)(rw + (size_t)(c + q) * 8 + 4);
#pragma unroll
                        for (int e = 0; e < 4; ++e) { lgt[e] += hv[q] * r0[e]; lgt[4 + e] += hv[q] * r1[e]; } } } } }
        if (ROUTER) {
#pragma unroll
            for (int e = 0; e < 8; ++e) lgt[e] = wave_sum(lgt[e]) + rb[e];
            int i1 = 0; float l1 = lgt[0];
#pragma unroll
            for (int e = 1; e < 8; ++e) if (lgt[e] > l1) { l1 = lgt[e]; i1 = e; }
            int i2 = -1; float l2 = -3.0e38f;
#pragma unroll
            for (int e = 0; e < 8; ++e) if (e != i1 && lgt[e] > l2) { l2 = lgt[e]; i2 = e; }
            const float ex = __expf(l2 - l1), den = 1.0f / (1.0f + ex);
            if (lane == 0) {
                const unsigned r1 = atomicAdd(ecnt + 64 * i1, 1u), r2 = atomicAdd(ecnt + 64 * (8 + i2), 1u);
                asg[row] = (i1 << 20) | (int)r1; asg[MTOK + row] = (i2 << 20) | (int)r2; agate[row] = den; agate[MTOK + row] = ex * den; }
        }
    }
}
__device__ __forceinline__ void phase_conv(const bf16_t* Z, const bf16_t* GB, const float* taps, bf16_t* A, int tid) {
    const int wid = tid >> 6, lane = tid & 63;
    for (int row = blockIdx.x * 8 + wid; row < MTOK; row += gridDim.x * 8) { const int t = row & 2047;
#pragma unroll
        for (int j = 0; j < 2; ++j) { const int c = 8 * lane + 512 * j;
            const u32x4 z2 = *(const u32x4*)(Z + (size_t)row * DM + c), gb = *(const u32x4*)(GB + (size_t)row * DM + c);
            u32x4 z1 = (u32x4){0u, 0u, 0u, 0u}, z0 = z1;
            if (t >= 1) z1 = *(const u32x4*)(Z + (size_t)(row - 1) * DM + c);
            if (t >= 2) z0 = *(const u32x4*)(Z + (size_t)(row - 2) * DM + c);
            u32x4 o;
#pragma unroll
            for (int q = 0; q < 4; ++q) { const int cc = c + 2 * q;
                const float a0 = bflo(gb[q]) * (taps[cc] * bflo(z0[q]) + taps[1024 + cc] * bflo(z1[q]) + taps[2048 + cc] * bflo(z2[q]));
                const float a1 = bfhi(gb[q]) * (taps[cc + 1] * bfhi(z0[q]) + taps[1024 + cc + 1] * bfhi(z1[q]) + taps[2048 + cc + 1] * bfhi(z2[q]));
                o[q] = cvt_pk_bf16(a0, a1); }
            *(u32x4*)(A + (size_t)row * DM + c) = o; } }
}
__device__ __forceinline__ void phase_moe_rows(unsigned char* ws, int tid) {
    unsigned* ctl = (unsigned*)(ws + WS_CTL); const int* asg = (const int*)(ws + WS_ASG); const float* agate = (const float*)(ws + WS_AGATE);
    int* rowtok = (int*)(ws + WS_ROWTOK); float* rowgate = (float*)(ws + WS_ROWGATE);
    int cnt[2][8], pst[2][8];
#pragma unroll
    for (int k = 0; k < 2; ++k) { int run = 0;
#pragma unroll
        for (int e = 0; e < 8; ++e) { cnt[k][e] = (int)xb_ld(ctl + CW_ECNT + 64 * (8 * k + e)); pst[k][e] = run; run += ((cnt[k][e] + 255) >> 8) << 8; } }
    const int gt = blockIdx.x * 512 + tid, GT = gridDim.x * 512;
    for (int idx = gt; idx < 2 * MTOK; idx += GT) { const int k = idx >= MTOK ? 1 : 0, tok = idx - k * MTOK; const int a = asg[idx], e = a >> 20, rk = a & 0xfffff;
        int ps = 0;
#pragma unroll
        for (int q = 0; q < 8; ++q) ps = (q == e) ? pst[k][q] : ps;
        const int row = ps + rk; rowtok[k * MOE_ROWS + row] = tok; rowgate[k * MOE_ROWS + row] = agate[idx]; }
    for (int idx = gt; idx < 2 * 8 * 256; idx += GT) { const int k = idx >> 11, e = (idx >> 8) & 7, q = idx & 255; int c = 0, ps = 0;
#pragma unroll
        for (int w = 0; w < 8; ++w) { c = (w == e) ? cnt[k][w] : c; ps = (w == e) ? pst[k][w] : ps; }
        const int row = ps + c + q, end = ps + (((c + 255) >> 8) << 8);
        if (row < end) { rowtok[k * MOE_ROWS + row] = -1; rowgate[k * MOE_ROWS + row] = 0.f; } }
    if (blockIdx.x == 0 && tid < 16) { const int k = tid >> 3, e = tid & 7; int te = 0;
#pragma unroll
        for (int w = 0; w < 8; ++w) if (w <= e) te += (cnt[k][w] + 255) >> 8;
        ctl[CW_TEND + 8 * k + e] = (unsigned)te; }
}

typedef short v4i16_t __attribute__((ext_vector_type(4)));
__device__ __forceinline__ f32x16 mfma32(bf16x8 a, bf16x8 b, f32x16 c) { return __builtin_amdgcn_mfma_f32_32x32x16_bf16(a, b, c, 0, 0, 0); }
__device__ __forceinline__ int crow(int r, int hi) { return (r & 3) + 8 * (r >> 2) + 4 * hi; }
__device__ __forceinline__ float xhalf_max(float v) { auto rr = __builtin_amdgcn_permlane32_swap(__float_as_uint(v), __float_as_uint(v), false, false); return fmaxf(__uint_as_float(rr[0]), __uint_as_float(rr[1])); }
__device__ __forceinline__ float xhalf_sum(float v) { auto rr = __builtin_amdgcn_permlane32_swap(__float_as_uint(v), __float_as_uint(v), false, false); return __uint_as_float(rr[0]) + __uint_as_float(rr[1]); }
struct KVStage { u32x4 k, v; };
__device__ __forceinline__ void kv_load(KVStage& s, const bf16_t* Kg, const bf16_t* Vg, int pitch, int key0, int wid, int lane) {
    s.k = *(const u32x4*)(Kg + (size_t)(key0 + lane) * pitch + wid * 8);
    s.v = *(const u32x4*)(Vg + (size_t)(key0 + 16 * (wid & 3) + (lane >> 2)) * pitch + (wid >> 2) * 32 + (lane & 3) * 8);
}
__device__ __forceinline__ void kv_store(const KVStage& s, LAS unsigned char* buf, int wid, int lane) {
    *(LAS u32x4*)(buf + wid * 1024 + lane * 16) = s.k;
    *(LAS u32x4*)(buf + 8192 + wid * 1024 + lane * 16) = s.v;
}
__device__ __forceinline__ void qk_tile(f32x16& s0, f32x16& s1, const LAS unsigned char* kb, const bf16x8 (&qr)[4], int r32, int hi) {
    s0 = (f32x16){}; s1 = (f32x16){};
#pragma unroll
    for (int d0 = 0; d0 < 4; ++d0) { const LAS unsigned char* p = kb + (2 * d0 + hi) * 1024 + r32 * 16;
        const bf16x8 k0 = *(const LAS bf16x8*)p, k1 = *(const LAS bf16x8*)(p + 512);
        s0 = mfma32(k0, qr[d0], s0); s1 = mfma32(k1, qr[d0], s1); }
}
__device__ __forceinline__ void pack_p(bf16x8 (&pb)[4], const f32x16& p0, const f32x16& p1) {
    u32x4 w;
    w.x = cvt_pk_bf16(p0[0], p0[1]); w.y = cvt_pk_bf16(p0[2], p0[3]); w.z = cvt_pk_bf16(p0[4], p0[5]); w.w = cvt_pk_bf16(p0[6], p0[7]); pb[0] = __builtin_bit_cast(bf16x8, w);
    w.x = cvt_pk_bf16(p0[8], p0[9]); w.y = cvt_pk_bf16(p0[10], p0[11]); w.z = cvt_pk_bf16(p0[12], p0[13]); w.w = cvt_pk_bf16(p0[14], p0[15]); pb[1] = __builtin_bit_cast(bf16x8, w);
    w.x = cvt_pk_bf16(p1[0], p1[1]); w.y = cvt_pk_bf16(p1[2], p1[3]); w.z = cvt_pk_bf16(p1[4], p1[5]); w.w = cvt_pk_bf16(p1[6], p1[7]); pb[2] = __builtin_bit_cast(bf16x8, w);
    w.x = cvt_pk_bf16(p1[8], p1[9]); w.y = cvt_pk_bf16(p1[10], p1[11]); w.z = cvt_pk_bf16(p1[12], p1[13]); w.w = cvt_pk_bf16(p1[14], p1[15]); pb[3] = __builtin_bit_cast(bf16x8, w);
}
__device__ __forceinline__ void pv_tile(f32x16& o0, f32x16& o1, const LAS unsigned char* vbuf, const bf16x8 (&pb)[4], int lane) {
    const int i = lane & 15, hi = lane >> 5;
    const LAS unsigned char* vb = vbuf + ((lane >> 4) & 1) * 32 + (i & 3) * 8 + (4 * hi + (i >> 2)) * 64;
#pragma unroll
    for (int ks = 0; ks < 4; ++ks) {
        const v4i16_t a0 = __builtin_amdgcn_ds_read_tr16_b64_v4i16((LAS v4i16_t*)(vb + ks * 1024));
        const v4i16_t a1 = __builtin_amdgcn_ds_read_tr16_b64_v4i16((LAS v4i16_t*)(vb + ks * 1024 + 512));
        const v4i16_t c0 = __builtin_amdgcn_ds_read_tr16_b64_v4i16((LAS v4i16_t*)(vb + 4096 + ks * 1024));
        const v4i16_t c1 = __builtin_amdgcn_ds_read_tr16_b64_v4i16((LAS v4i16_t*)(vb + 4096 + ks * 1024 + 512));
        const bf16x8 va = (bf16x8){a0[0], a0[1], a0[2], a0[3], a1[0], a1[1], a1[2], a1[3]};
        const bf16x8 vc = (bf16x8){c0[0], c0[1], c0[2], c0[3], c1[0], c1[1], c1[2], c1[3]};
        o0 = mfma32(va, pb[ks], o0); o1 = mfma32(vc, pb[ks], o1); }
}
__device__ __forceinline__ void store_ot(LAS unsigned char* stg, const f32x16& o0, const f32x16& o1, bf16_t* Og, int pitch, int lane) {
    const int r32 = lane & 31, hi = lane >> 5;
#pragma unroll
    for (int r = 0; r < 16; r += 2) { const int d = crow(r, hi);
        *(LAS unsigned*)(stg + r32 * 128 + d * 2) = cvt_pk_bf16(o0[r], o0[r + 1]);
        *(LAS unsigned*)(stg + r32 * 128 + 64 + d * 2) = cvt_pk_bf16(o1[r], o1[r + 1]); }
    asm volatile("s_waitcnt lgkmcnt(0)" ::: "memory");
#pragma unroll
    for (int i = 0; i < 4; ++i) { const int row = i * 8 + (lane >> 3), ch = lane & 7; const u32x4 v = *(const LAS u32x4*)(stg + row * 128 + ch * 16);
        *(u32x4*)(Og + (size_t)row * pitch + ch * 8) = v; }
    asm volatile("s_waitcnt lgkmcnt(0)" ::: "memory");
}

#define CK(a, r) (32 * (a) + ((r) & 3) + 8 * ((r) >> 2))
constexpr int ATT_RING = 0, ATT_SLOT = 16384, ATT_IMP = 65536, ATT_SEL = ATT_IMP + 4 * 64 * 33 * 4, ATT_DONE = ATT_SEL + 256, ATT_WQ = ATT_DONE + 64;
__device__ __forceinline__ int wq_next(unsigned* head, LAS unsigned char* lds, int tid) {
    __syncthreads();
    if (tid == 0) *(volatile LAS unsigned*)(lds + ATT_WQ) = atomicAdd(head, 1u);
    __syncthreads();
    return (int)*(volatile LAS unsigned*)(lds + ATT_WQ);
}
__device__ __forceinline__ void glds16(const void* gsrc, unsigned lds_dst) { unsigned keep;
    asm volatile("s_mov_b32 %0, m0\n\ts_mov_b32 m0, %2\n\ts_nop 0\n\tglobal_load_lds_dwordx4 %1, off\n\ts_mov_b32 m0, %0" : "=&s"(keep) : "v"(gsrc), "s"(lds_dst) : "memory"); }
__device__ __forceinline__ void kv_dma(LAS unsigned char* slot, const bf16_t* Kg, const bf16_t* Vg, int pitch, int key0, int wid, int lane) {
    const bf16_t* kp = Kg + (size_t)(key0 + lane) * pitch + wid * 8;
    const bf16_t* vp = Vg + (size_t)(key0 + 16 * (wid & 3) + (lane >> 2)) * pitch + (wid >> 2) * 32 + (lane & 3) * 8;
    const unsigned dst = (unsigned)__builtin_amdgcn_readfirstlane((int)(unsigned)(uintptr_t)(slot + wid * 1024));
    glds16(kp, dst); glds16(vp, dst + 8192u);
}
__device__ __forceinline__ void kv_dma_img(LAS unsigned char* slot, const unsigned char* Kimg, const unsigned char* Vimg, int wid, int lane) {
    const unsigned dst = (unsigned)__builtin_amdgcn_readfirstlane((int)(unsigned)(uintptr_t)(slot + wid * 1024));
    glds16(Kimg + wid * 1024 + lane * 16, dst); glds16(Vimg + wid * 1024 + lane * 16, dst + 8192u);
}
__device__ __forceinline__ void wait_bar(int ny) {
    if (ny >= 2) asm volatile("s_waitcnt vmcnt(4) lgkmcnt(0)\n\ts_barrier" ::: "memory");
    else if (ny == 1) asm volatile("s_waitcnt vmcnt(2) lgkmcnt(0)\n\ts_barrier" ::: "memory");
    else asm volatile("s_waitcnt vmcnt(0) lgkmcnt(0)\n\ts_barrier" ::: "memory");
}

constexpr float SB_DONE = 160.0f;
__device__ __forceinline__ void sb_unit(LAS unsigned char* lds, const bf16_t* Q, const unsigned char* SBK, const unsigned char* SBV, bf16_t* O, int b, int h, int qb, int wid, int lane) {
    const int r32 = lane & 31, hi = lane >> 5;
    const int qw = qb * 256 + wid * 32, tq = qw + r32;
    const bf16_t* Qp = Q + (size_t)(b * SEQ + tq) * DM + h * 64;
    bf16x8 qr[4];
#pragma unroll
    for (int d0 = 0; d0 < 4; ++d0) qr[d0] = *(const bf16x8*)(Qp + d0 * 16 + hi * 8);
    asm volatile("" : "+v"(qr[0]), "+v"(qr[1]), "+v"(qr[2]), "+v"(qr[3]));
    bf16x8 tri[2], ones;
#pragma unroll
    for (int s = 0; s < 2; ++s)
#pragma unroll
        for (int j = 0; j < 8; ++j) tri[s][j] = (16 * s + 8 * (j >> 2) + 4 * hi + (j & 3) > r32) ? (short)0x3F80 : (short)0;
#pragma unroll
    for (int j = 0; j < 8; ++j) ones[j] = (short)0x3F80;
    const unsigned char* Kimg = SBK + (size_t)((b * 8 + h) * 32) * 8192; const unsigned char* Vimg = SBV + (size_t)((b * 8 + h) * 32) * 8192;
    f32x16 o0 = (f32x16){}, o1 = (f32x16){}; float C = 0.f;
    const int nel = 4 * (qb + 1);
    LAS unsigned char* ring = lds + ATT_RING; LAS unsigned* DONE = (LAS unsigned*)(lds + ATT_DONE);
#pragma unroll
    for (int e = 0; e < 3; ++e) if (e < nel) kv_dma_img(ring + e * ATT_SLOT, Kimg + (size_t)(nel - 1 - e) * 8192, Vimg + (size_t)(nel - 1 - e) * 8192, wid, lane);
    bool wdone = false;
    for (int i = 0; i < nel; ++i) {
        const int jt = nel - 1 - i; const int li = (i + 2 < nel - 1) ? i + 2 : nel - 1;
        wait_bar(li - i);
        if (i > 0) { const unsigned f = DONE[(i & 1) * 8 + (lane & 7)]; if (__all(f != 0u)) break; }
        if (i + 3 < nel) kv_dma_img(ring + ((i + 3) & 3) * ATT_SLOT, Kimg + (size_t)(nel - 4 - i) * 8192, Vimg + (size_t)(nel - 4 - i) * 8192, wid, lane);
        const LAS unsigned char* buf = ring + (i & 3) * ATT_SLOT;
        if (!wdone && 64 * jt <= qw + 30) {
            f32x16 s0, s1; qk_tile(s0, s1, buf, qr, r32, hi);
            u32x4 wh[4], wl[4]; f32x2 tot2 = (f32x2){0.f, 0.f}; float tot;
            const int lim = tq - 64 * jt - 4 * hi;
#define SB_SPLUS(z) (fmaxf((z), 0.f) + fast_log2(1.0f + fast_exp2(-fabsf(z))))
#define SB_HI(x) __uint_as_float(__float_as_uint(x) & 0xffff0000u)
#define SB_PAIR(S, A, r, MASKED) do { float pa_ = SB_SPLUS(S[r]), pb2_ = SB_SPLUS(S[(r) + 1]); \
                if (MASKED) { const bool va_ = CK((A), (r)) < lim, vb_ = CK((A), (r) + 1) < lim; S[r] = va_ ? S[r] - pa_ : -1.0e30f; S[(r) + 1] = vb_ ? S[(r) + 1] - pb2_ : -1.0e30f; pa_ = va_ ? pa_ : 0.f; pb2_ = vb_ ? pb2_ : 0.f; } \
                else { S[r] -= pa_; S[(r) + 1] -= pb2_; } \
                tot2 += (f32x2){pa_, pb2_}; \
                wh[2 * (A) + ((r) >> 3)][((r) >> 1) & 3] = (__float_as_uint(pa_) >> 16) | (__float_as_uint(pb2_) & 0xffff0000u); \
                wl[2 * (A) + ((r) >> 3)][((r) >> 1) & 3] = cvt_pk_bf16(pa_ - SB_HI(pa_), pb2_ - SB_HI(pb2_)); } while (0)
            if (64 * jt + 63 < qw) {
#pragma unroll
                for (int r = 0; r < 16; r += 2) { SB_PAIR(s0, 0, r, false); SB_PAIR(s1, 1, r, false); }
            } else {
#pragma unroll
                for (int r = 0; r < 16; r += 2) { SB_PAIR(s0, 0, r, true); SB_PAIR(s1, 1, r, true); }
            }
#undef SB_PAIR
#undef SB_HI
#undef SB_SPLUS
            tot = tot2[0] + tot2[1];
            bf16x8 bh[4], bl[4];
#pragma unroll
            for (int q = 0; q < 4; ++q) { bh[q] = __builtin_bit_cast(bf16x8, wh[q]); bl[q] = __builtin_bit_cast(bf16x8, wl[q]); }
            f32x16 L0, L1;
#pragma unroll
            for (int r = 0; r < 16; ++r) { L0[r] = C; L1[r] = C; }
            L0 = mfma32(tri[0], bh[0], L0); L0 = mfma32(tri[0], bl[0], L0); L0 = mfma32(tri[1], bh[1], L0); L0 = mfma32(tri[1], bl[1], L0);
            L0 = mfma32(ones, bh[2], L0); L0 = mfma32(ones, bl[2], L0); L0 = mfma32(ones, bh[3], L0); L0 = mfma32(ones, bl[3], L0);
            L1 = mfma32(tri[0], bh[2], L1); L1 = mfma32(tri[0], bl[2], L1); L1 = mfma32(tri[1], bh[3], L1); L1 = mfma32(tri[1], bl[3], L1);
            C += xhalf_sum(tot);
#pragma unroll
            for (int r = 0; r < 16; ++r) { s0[r] = fast_exp2(s0[r] - L0[r]); s1[r] = fast_exp2(s1[r] - L1[r]); }
            bf16x8 pb[4]; pack_p(pb, s0, s1);
            pv_tile(o0, o1, buf + 8192, pb, lane);
            wdone = __all(C > SB_DONE);
        }
        if (lane == 0) DONE[((i + 1) & 1) * 8 + wid] = wdone ? 1u : 0u;
    }
    asm volatile("s_waitcnt vmcnt(0) lgkmcnt(0)\n\ts_barrier" ::: "memory");
    store_ot(ring + wid * 4096, o0, o1, O + (size_t)(b * SEQ + qw) * DM + h * 64, DM, lane);
}

__device__ __forceinline__ void qk_tile_c(f32x16& s0, f32x16& s1, const LAS unsigned char* kb, const bf16x8 (&qr)[4], const f32x16& cini, int r32, int hi) {
    s0 = cini; s1 = cini;
#pragma unroll
    for (int d0 = 0; d0 < 4; ++d0) { const LAS unsigned char* p = kb + (2 * d0 + hi) * 1024 + r32 * 16;
        const bf16x8 k0 = *(const LAS bf16x8*)p, k1 = *(const LAS bf16x8*)(p + 512);
        s0 = mfma32(k0, qr[d0], s0); s1 = mfma32(k1, qr[d0], s1); }
}
#define MAX3(a, b, c) __builtin_fmaxf(__builtin_fmaxf((a), (b)), (c))
constexpr float SM_THR = 8.0f;
#define SM_TILE(buf, c0, MASK, lim_, dbase_, first_) do { \
        f32x16 ci_; _Pragma("unroll") for (int r = 0; r < 16; ++r) ci_[r] = (c0); \
        f32x16 s0_, s1_; qk_tile_c(s0_, s1_, (buf), qr, ci_, r32, hi); \
        if ((MASK) == 1) { _Pragma("unroll") for (int r = 0; r < 16; ++r) { s0_[r] = (CK(0, r) <= (lim_)) ? s0_[r] : -1.0e30f; s1_[r] = (CK(1, r) <= (lim_)) ? s1_[r] : -1.0e30f; } } \
        if ((MASK) == 2) { _Pragma("unroll") for (int r = 0; r < 16; ++r) { s0_[r] = ((unsigned)((dbase_) - CK(0, r)) < 512u) ? s0_[r] : -1.0e30f; s1_[r] = ((unsigned)((dbase_) - CK(1, r)) < 512u) ? s1_[r] : -1.0e30f; } } \
        float ma_ = MAX3(s0_[0], s0_[1], s1_[0]), mb_ = MAX3(s0_[2], s0_[3], s1_[1]); ma_ = MAX3(ma_, s1_[2], s1_[3]); \
        _Pragma("unroll") for (int r = 4; r < 16; r += 4) { ma_ = MAX3(ma_, s0_[r], s0_[r + 1]); mb_ = MAX3(mb_, s0_[r + 2], s0_[r + 3]); ma_ = MAX3(ma_, s1_[r], s1_[r + 1]); mb_ = MAX3(mb_, s1_[r + 2], s1_[r + 3]); } \
        const float mx_ = xhalf_max(fmaxf(ma_, mb_)); \
        if (__any(mx_ > SM_THR) || (first_)) { const float dl_ = (first_) ? fmaxf(mx_, -100.f) : fmaxf(mx_, 0.f), al_ = fast_exp2(-dl_); m_run += dl_; l_run *= al_;   \
            _Pragma("unroll") for (int r = 0; r < 16; ++r) { s0_[r] -= dl_; s1_[r] -= dl_; oa0[r] *= al_; oa1[r] *= al_; } } \
        f32x2 ps_ = (f32x2){0.f, 0.f}; \
        _Pragma("unroll") for (int r = 0; r < 16; ++r) { s0_[r] = fast_exp2(s0_[r]); s1_[r] = fast_exp2(s1_[r]); ps_ += (f32x2){s0_[r], s1_[r]}; } \
        l_run += ps_[0] + ps_[1]; \
        bf16x8 pb_[4]; pack_p(pb_, s0_, s1_); pv_tile(oa0, oa1, (buf) + 8192, pb_, lane); } while (0)

__device__ __forceinline__ void nsa_unit(LAS unsigned char* lds, const bf16_t* Q, const unsigned char* NSAI, const bf16_t* KCV, const float* GATE, bf16_t* O, int b, int g, int tb, int wid, int lane) {
    const int r32 = lane & 31, hi = lane >> 5, rh = wid & 3, th = wid >> 2;
    const int tloc = 32 * th + r32, t = 64 * tb + tloc; const size_t row = (size_t)b * SEQ + t;
    bf16x8 qr[4];
    { const bf16_t* Qp = Q + row * DM + 512 + (g * 4 + rh) * 64;
#pragma unroll
      for (int d0 = 0; d0 < 4; ++d0) qr[d0] = *(const bf16x8*)(Qp + d0 * 16 + hi * 8); }
    const float* gp = GATE + row * 32 + g * 12 + rh * 3;
    float gt0 = gp[0], gt1 = gp[1], gt2 = gp[2];
    asm volatile("" : "+v"(qr[0]), "+v"(qr[1]), "+v"(qr[2]), "+v"(qr[3]), "+v"(gt0), "+v"(gt1), "+v"(gt2));
    f32x16 tot0, tot1;
    LAS unsigned char* ring = lds + ATT_RING;
    const unsigned char* ImS = NSAI + (size_t)(((0 * 16 + b) * 2 + g) * 32) * 8192; const unsigned char* ImW = NSAI + (size_t)(((2 * 16 + b) * 2 + g) * 32) * 8192;
    constexpr size_t VOFF = (size_t)16 * 2 * 32 * 8192;
    const int jw0 = tb >= 8 ? tb - 8 : 0, nwin = tb - jw0 + 1, nel = nwin + tb + 1;
#define EL_DMA(e, slotp) do { const unsigned char* ki_ = ((e) < nwin) ? ImW + (size_t)(jw0 + (e)) * 8192 : ImS + (size_t)((e) - nwin) * 8192; kv_dma_img((slotp), ki_, ki_ + VOFF, wid, lane); } while (0)
    {
        const bf16_t* Kc = KCV + (size_t)((b * 2 + g) * 128) * 64; const bf16_t* Vc = Kc + (size_t)4096 * 64;
        kv_dma(ring, Kc, Vc, 64, 0, wid, lane); kv_dma(ring + ATT_SLOT, Kc, Vc, 64, 64, wid, lane);
        EL_DMA(0, ring + 2 * ATT_SLOT); EL_DMA(1, ring + 3 * ATT_SLOT);
        wait_bar(2);
    }
    {
        f32x16 p[4];
        qk_tile(p[0], p[1], ring, qr, r32, hi); qk_tile(p[2], p[3], ring + ATT_SLOT, qr, r32, hi);
        float mx = -1.0e30f; const int tcmp = t - 31 - 64 * hi;
#pragma unroll
        for (int a = 0; a < 4; ++a)
#pragma unroll
            for (int r = 0; r < 16; ++r) { p[a][r] = (16 * CK(a, r) <= tcmp) ? p[a][r] : -1.0e30f; mx = fmaxf(mx, p[a][r]); }
        mx = fmaxf(xhalf_max(mx), -1.0e29f);
        float ls = 0.f;
#pragma unroll
        for (int a = 0; a < 4; ++a)
#pragma unroll
            for (int r = 0; r < 16; ++r) { p[a][r] = fast_exp2(p[a][r] - mx); ls += p[a][r]; }
        ls = xhalf_sum(ls); const float inv = ls > 0.f ? 1.0f / ls : 0.f;
#pragma unroll
        for (int a = 0; a < 4; ++a)
#pragma unroll
            for (int r = 0; r < 16; ++r) p[a][r] *= inv;
        LAS float* impw = (LAS float*)(lds + ATT_IMP) + (rh * 64 + tloc) * 33;
        float carry = 0.f;
#pragma unroll
        for (int a = 0; a < 4; ++a) {
            const float e0 = __shfl_xor(p[a][3], 32), e1 = __shfl_xor(p[a][7], 32), e2 = __shfl_xor(p[a][11], 32), e3 = __shfl_xor(p[a][15], 32);
            const float o0 = (p[a][0] + p[a][1]) + (p[a][2] + p[a][3]), o1 = (p[a][4] + p[a][5]) + (p[a][6] + p[a][7]);
            const float o2 = (p[a][8] + p[a][9]) + (p[a][10] + p[a][11]), o3 = (p[a][12] + p[a][13]) + (p[a][14] + p[a][15]);
            impw[8 * a + 0 + hi] = o0 + (hi ? e0 : carry);
            impw[8 * a + 2 + hi] = o1 + (hi ? e1 : e0);
            impw[8 * a + 4 + hi] = o2 + (hi ? e2 : e1);
            impw[8 * a + 6 + hi] = o3 + (hi ? e3 : e2);
            carry = e3; }
#pragma unroll
        for (int a = 0; a < 4; ++a)
#pragma unroll
            for (int r = 0; r < 16; ++r) p[a][r] *= gt0;
        tot0 = (f32x16){}; tot1 = (f32x16){};
        { bf16x8 pb[4]; pack_p(pb, p[0], p[1]); pv_tile(tot0, tot1, ring + 8192, pb, lane); }
        { bf16x8 pb[4]; pack_p(pb, p[2], p[3]); pv_tile(tot0, tot1, ring + ATT_SLOT + 8192, pb, lane); }
    }
    f32x16 oa0 = (f32x16){}, oa1 = (f32x16){}; float m_run = 0.f, l_run = 0.f; unsigned selmask = 0u;
    for (int i = 0; i < nel; ++i) {
        const int li = (i == 0) ? 1 : ((i + 2 < nel - 1) ? i + 2 : nel - 1);
        wait_bar(li - i);
        if (i == 0) { if (2 < nel) EL_DMA(2, ring); if (3 < nel) EL_DMA(3, ring + ATT_SLOT); }
        else if (i + 3 < nel) EL_DMA(i + 3, ring + ((i + 5) & 3) * ATT_SLOT);
        if (i == 0) {
            const LAS float* imp = (const LAS float*)(lds + ATT_IMP);
            LAS unsigned* SEL = (LAS unsigned*)(lds + ATT_SEL);
#pragma unroll 1
            for (int it = 0; it < 4; ++it) { const int tl = 8 * wid + 2 * it + hi, sb = r32;
                const float v = ((imp[(0 * 64 + tl) * 33 + sb] + imp[(1 * 64 + tl) * 33 + sb]) + imp[(2 * 64 + tl) * 33 + sb]) + imp[(3 * 64 + tl) * 33 + sb];
                const bool valid = sb <= tb, forced = (sb == 0) || (sb == tb) || (sb == tb - 1);
                const float val = valid ? (forced ? 1.0e30f : v) : -1.0e30f;
                int rank = 0;
#pragma unroll 8
                for (int s2 = 0; s2 < 32; ++s2) { const float o = __shfl(val, (lane & 32) | s2); rank += ((o > val) || (o == val && s2 < sb)) ? 1 : 0; }
                const unsigned long long bal = __ballot(rank < 16);
                if (lane == 0) { SEL[8 * wid + 2 * it] = (unsigned)bal; SEL[8 * wid + 2 * it + 1] = (unsigned)(bal >> 32); } }
        }
        if (i == nwin) {
            const float lt = xhalf_sum(l_run); const float sc = (lt > 0.f ? 1.0f / lt : 0.f) * gt2;
#pragma unroll
            for (int r = 0; r < 16; ++r) { tot0[r] += sc * oa0[r]; tot1[r] += sc * oa1[r]; oa0[r] = 0.f; oa1[r] = 0.f; }
            m_run = 0.f; l_run = 0.f;
            selmask = *(const LAS unsigned*)(lds + ATT_SEL + tloc * 4);
        }
        const LAS unsigned char* buf = ring + ((i + 2) & 3) * ATT_SLOT;
        if (i < nwin) { const int j = jw0 + i; const int dbase = 64 * (tb - j) + tloc - 4 * hi;
            if (j == tb || (tb >= 8 && j == jw0)) SM_TILE(buf, -m_run, 2, 0, dbase, i == 0);
            else SM_TILE(buf, -m_run, 0, 0, 0, i == 0);
        } else { const int j = i - nwin; const bool rs = (selmask >> j) & 1u;
            if (j == tb) { const int lim = tloc - 4 * hi; SM_TILE(buf, -m_run, 1, lim, 0, j == 0); }
            else { const float c0 = rs ? -m_run : -1.0e30f; SM_TILE(buf, c0, 0, 0, 0, j == 0); }
        }
    }
    { const float lt = xhalf_sum(l_run); const float sc = (lt > 0.f ? 1.0f / lt : 0.f) * gt1;
#pragma unroll
      for (int r = 0; r < 16; ++r) { tot0[r] += sc * oa0[r]; tot1[r] += sc * oa1[r]; } }
    asm volatile("s_waitcnt vmcnt(0) lgkmcnt(0)\n\ts_barrier" ::: "memory");
    store_ot(ring + wid * 4096, tot0, tot1, O + ((size_t)b * SEQ + 64 * tb + 32 * th) * DM + 512 + (g * 4 + rh) * 64, DM, lane);
#undef EL_DMA
}
#undef SM_TILE
#undef MAX3

#ifndef PHSEL
#define PHSEL 0xffffffffu
#endif
#ifndef ATTREP
#define ATTREP 1
#endif
#ifndef REPMASK
#define REPMASK 0u
#endif
#define PH(n) _Pragma("unroll") for (int rep_ = 0; rep_ < (int)(((PHSEL >> (n)) & 1u) + ((REPMASK >> (n)) & 1u)); ++rep_)
__global__ void __launch_bounds__(512, 2) hybrid_fwd(Args a) {
    extern __shared__ __attribute__((aligned(16))) unsigned char lds_raw[];
    LAS unsigned char* lds = (LAS unsigned char*)lds_raw;
    const int tid0 = threadIdx.x;
    const int G = gridDim.x, bx = blockIdx.x;
    unsigned char* ws = a.ws;
    unsigned* ctl = (unsigned*)(ws + WS_CTL);
    volatile LAS unsigned* MISC = (volatile LAS unsigned*)(lds + MISC_OFF);
    if (tid0 < 32) MISC[tid0] = 0u;
    __syncthreads();
    XcdBarrier bar = xcd_barrier_post(ctl + CW_BAR, MISC + 8);
#define GRID_BAR() xcd_barrier(bar)
    float* MOD = (float*)(ws + WS_MOD);
    const float* MOD0 = MOD; const float* MOD1 = MOD + 16 * 6144;
    bf16_t* R1 = (bf16_t*)(ws + WS_R1); bf16_t* R2 = (bf16_t*)(ws + WS_R2); bf16_t* R3 = (bf16_t*)(ws + WS_R3);
    bf16_t* KC = (bf16_t*)(ws + R3_KC); float* GATE = (float*)(ws + R3_GATE); bf16_t* HID = (bf16_t*)(ws + R3_HID); bf16_t* KCV = (bf16_t*)(ws + R3_KCV);

    PH(0) phase_prologue(a, lds, opaque_tid());
    GRID_BAR();
    PH(1) phase_modulate(a.x, MOD0 + 1024, MOD0, R1, opaque_tid());
    GRID_BAR();
    PH(2) { pg8::Gemm g{R1, (const bf16_t*)(ws + W_MIX), DM, DM, nullptr}; GridOrder S; S.init(MTOK / 256, MIXNP / 256, G, bx);
      EpiMix E{(bf16_t*)(ws + R2_Q), ws + R2_SBK, ws + R2_SBV, ws + R2_NSA, KC, GATE};
      pg8::gemm_phase<EpiMix, GridOrder, true, false>(lds, g, S, E); }
    GRID_BAR();
    PH(3) if (bx < 32) {
        { pg8::Gemm g{KC, (const bf16_t*)(ws + W_C1), 1024, 2048, nullptr}; CmpOrder S{G, bx};
          EpiPlain<1> E{HID, 256, (const float*)(ws + WS_CBIAS), 256, 1};
          pg8::gemm_phase<EpiPlain<1>, CmpOrder, false, false>(lds, g, S, E); }
        asm volatile("s_waitcnt vmcnt(0)" ::: "memory"); __syncthreads();
        __builtin_amdgcn_fence(__ATOMIC_ACQUIRE, "agent"); asm volatile("s_waitcnt vmcnt(0)" ::: "memory"); __syncthreads();
        { pg8::Gemm g{HID, (const bf16_t*)(ws + W_C2), 256, 256, nullptr}; CmpOrder S{G, bx};
          EpiPlain<0> E{KCV, 64, nullptr, 64, 1};
          pg8::gemm_phase<EpiPlain<0>, CmpOrder, false, false>(lds, g, S, E); }
    }
    PH(4) { const int tid = opaque_tid(), lane = tid & 63, wid = __builtin_amdgcn_readfirstlane(tid >> 6);
      for (;;) { const int u = wq_next(ctl + CW_WQ, lds, opaque_tid()); if (u >= 1024) break;
        for (int q_ = 0; q_ < ATTREP; ++q_) { sb_unit(lds, (const bf16_t*)(ws + R2_Q), ws + R2_SBK, ws + R2_SBV, R1, (u & 127) >> 3, u & 7, 7 - (u >> 7), wid, lane); __syncthreads(); } } }
    GRID_BAR();
    PH(5) { const int tid = opaque_tid(), lane = tid & 63, wid = __builtin_amdgcn_readfirstlane(tid >> 6);
      for (;;) { const int u = wq_next(ctl + CW_WQ + 64, lds, opaque_tid()); if (u >= 1024) break;
        for (int q_ = 0; q_ < ATTREP; ++q_) { nsa_unit(lds, (const bf16_t*)(ws + R2_Q), ws + R2_NSA, KCV, GATE, R1, (u & 31) >> 1, u & 1, 31 - (u >> 5), wid, lane); __syncthreads(); } } }
    GRID_BAR();
    PH(6) { pg8::Gemm g{R1, (const bf16_t*)(ws + W_OUT), DM, DM, nullptr}; GridOrder S; S.init(MTOK / 256, 4, G, bx);
      EpiPlain<0> E{R3, DM, nullptr, DM, 4};
      pg8::gemm_phase<EpiPlain<0>, GridOrder, true, false>(lds, g, S, E); }
    GRID_BAR();
    PH(7) phase_ln<true, true, false>(a.x, DN_ALPHA, R3, MOD0 + 2048, a.ln_g, a.ln_b, a.out, R1, MOD0 + 4096, MOD0 + 3072, nullptr, nullptr, nullptr, nullptr, nullptr, opaque_tid());
    GRID_BAR();
    PH(8) { pg8::Gemm g{R1, (const bf16_t*)(ws + W_F13), DM, DM, nullptr}; GridOrder S; S.init(MTOK / 256, 22, G, bx);
      EpiSwiGLU E{R2, DFF, 22};
      pg8::gemm_phase<EpiSwiGLU, GridOrder, true, false>(lds, g, S, E); }
    GRID_BAR();
    PH(9) { pg8::Gemm g{R2, (const bf16_t*)(ws + W_F2), DFF, DFF, nullptr}; GridOrder S; S.init(MTOK / 256, 4, G, bx);
      EpiPlain<0> E{R3, DM, nullptr, DM, 4};
      pg8::gemm_phase<EpiPlain<0>, GridOrder, true, false>(lds, g, S, E); }
    GRID_BAR();
    PH(10) phase_ln<true, true, false>(a.out, DN_ALPHA, R3, MOD0 + 5120, a.ln_g + 1024, a.ln_b + 1024, a.out, R1, MOD1 + 1024, MOD1, nullptr, nullptr, nullptr, nullptr, nullptr, opaque_tid());
    GRID_BAR();
    PH(11) { pg8::Gemm g{R1, (const bf16_t*)(ws + W_CIN), DM, DM, nullptr}; GridOrder S; S.init(MTOK / 256, 12, G, bx);
      EpiConvIn E{R2, R2 + (size_t)MTOK * DM};
      pg8::gemm_phase<EpiConvIn, GridOrder, true, false>(lds, g, S, E); }
    GRID_BAR();
    PH(12) phase_conv(R2, R2 + (size_t)MTOK * DM, a.conv_taps, R3, opaque_tid());
    GRID_BAR();
    PH(13) { pg8::Gemm g{R3, (const bf16_t*)(ws + W_COUT), DM, DM, nullptr}; GridOrder S; S.init(MTOK / 256, 4, G, bx);
      EpiPlain<0> E{R1, DM, nullptr, DM, 4};
      pg8::gemm_phase<EpiPlain<0>, GridOrder, true, false>(lds, g, S, E); }
    GRID_BAR();
    PH(14) phase_ln<true, true, true>(a.out, DN_ALPHA, R1, MOD1 + 2048, a.ln_g + 2048, a.ln_b + 2048, a.out, R3, MOD1 + 4096, MOD1 + 3072, a.router_w, a.router_b,
                               ctl + CW_ECNT, (int*)(ws + WS_ASG), (float*)(ws + WS_AGATE), opaque_tid());
    GRID_BAR();
    PH(15) phase_moe_rows(ws, opaque_tid());
    GRID_BAR();
    { __syncthreads();
      if (tid0 < 16) ((LAS unsigned*)(lds + MISC_OFF + 256))[tid0] = xb_ld(ctl + CW_TEND + tid0);
      __syncthreads(); }
    {
    const LAS unsigned* tendL = (const LAS unsigned*)(lds + MISC_OFF + 256);
    const int nt0 = __builtin_amdgcn_readfirstlane((int)tendL[7]), nt1 = __builtin_amdgcn_readfirstlane((int)tendL[15]);
    const int n0a = nt0 < 58 ? nt0 : 58, n1a = nt1 > 64 ? nt1 - 64 : 0;
    unsigned char* const actbuf0 = ws + WS_R1; unsigned char* const actbuf1 = ws + WS_R1 + 120 * MiB;
#pragma unroll 1
    for (int ph = 0; ph < 5; ++ph) {
        int dh = 0;
        if (ph > 0) { const int cd = ph - 1, k = cd >> 1, lo = (cd & 1) ? (k ? n1a : n0a) : 0, hi = (cd & 1) ? (k ? nt1 : nt0) : (k ? n1a : n0a);
            const int* rowtok = (const int*)(ws + WS_ROWTOK) + k * MOE_ROWS; const float* rowgate = (const float*)(ws + WS_ROWGATE) + k * MOE_ROWS;
            const bf16_t* ab = (const bf16_t*)((cd & 1) ? actbuf1 : actbuf0) - (size_t)lo * 256 * DFF;
            MoeOrder S; S.G = G; S.c = bx; S.NJ = 4; S.lo = lo; S.ntiles = hi - lo; S.dh = 0; S.early = 0; S.tend = tendL + 8 * k;
            dh = ((hi - lo) * 4) % G;
            PH(17) { pg8::Gemm g{ab, (const bf16_t*)(ws + W_E2), DFF, DFF, nullptr};
              EpiMoeDown E{a.out, rowtok, rowgate, MOD1 + 5120, k == 0 ? DN_ALPHA : 1.0f, 1.0f}; pg8::gemm_phase<EpiMoeDown, MoeOrder, true, false>(lds, g, S, E); } }
        if (ph < 4) { const int cu = ph, k = cu >> 1, lo = (cu & 1) ? (k ? n1a : n0a) : 0, hi = (cu & 1) ? (k ? nt1 : nt0) : (k ? n1a : n0a);
            const int* rowtok = (const int*)(ws + WS_ROWTOK) + k * MOE_ROWS;
            bf16_t* ab = (bf16_t*)((cu & 1) ? actbuf1 : actbuf0) - (size_t)lo * 256 * DFF;
            MoeOrder S; S.G = G; S.c = bx; S.NJ = 22; S.lo = lo; S.ntiles = hi - lo; S.dh = dh; S.early = dh ? 3 : 0; S.tend = tendL + 8 * k;
            PH(16) { pg8::Gemm g{R3, (const bf16_t*)(ws + W_E13), DM, DM, rowtok};
              EpiSwiGLU E{ab, DFF, 22};
              pg8::gemm_phase<EpiSwiGLU, MoeOrder, true, true>(lds, g, S, E); } }
        GRID_BAR();
    }
    }
    PH(18) phase_ln<false, false, false>(a.out, 1.0f, nullptr, nullptr, a.ln_g + 3072, a.ln_b + 3072, a.out, nullptr, nullptr, nullptr, nullptr, nullptr, nullptr, nullptr, nullptr, opaque_tid());
#undef GRID_BAR
}

extern "C" void kernel_launch(void* const* d_in, const int* in_sizes, int n_in, void* d_out, int out_size, void* d_ws, size_t ws_size, hipStream_t stream) {
    static int grid = 0;
    if (grid == 0) {
        if (n_in != 22 || in_sizes[0] != MTOK * DM || out_size != MTOK * DM || ws_size < WS_END) {
            fprintf(stderr, "kernel_launch: unexpected problem (n_in %d, in0 %d, out %d, ws %zu); nothing launched\n", n_in, n_in > 0 ? in_sizes[0] : -1, out_size, ws_size); grid = -1; return; }
        int dev = 0, cus = 0, per_cu = 0;
        if (hipGetDevice(&dev) != hipSuccess || hipDeviceGetAttribute(&cus, hipDeviceAttributeMultiprocessorCount, dev) != hipSuccess) { grid = -1; return; }
        if (hipFuncSetAttribute((const void*)hybrid_fwd, hipFuncAttributeMaxDynamicSharedMemorySize, LDS_BYTES) != hipSuccess) { fprintf(stderr, "kernel_launch: hipFuncSetAttribute failed\n"); grid = -1; return; }
        if (hipOccupancyMaxActiveBlocksPerMultiprocessor(&per_cu, (const void*)hybrid_fwd, 512, LDS_BYTES) != hipSuccess || per_cu < 1)
            fprintf(stderr, "kernel_launch: note: occupancy query reports %d workgroups per CU\n", per_cu);
        (void)hipGetLastError();
        grid = cus;
    }
    if (grid < 0) return;
    if (hipMemsetAsync((char*)d_ws + WS_CTL, 0, CTL_BYTES, stream) != hipSuccess) { fprintf(stderr, "kernel_launch: hipMemsetAsync failed\n"); return; }
    Args a{};
    a.x = (const float*)d_in[0]; a.c = (const float*)d_in[1]; a.ada_w = (const float*)d_in[2]; a.ada_b = (const float*)d_in[3]; a.ln_g = (const float*)d_in[4]; a.ln_b = (const float*)d_in[5];
    a.mix_w_in = (const float*)d_in[6]; a.cmp_pos = (const float*)d_in[7]; a.cmp_w1 = (const float*)d_in[8]; a.cmp_w2 = (const float*)d_in[9]; a.mix_w_out = (const float*)d_in[10];
    a.ffn_w1 = (const float*)d_in[11]; a.ffn_w3 = (const float*)d_in[12]; a.ffn_w2 = (const float*)d_in[13]; a.conv_w_in = (const float*)d_in[14]; a.conv_taps = (const float*)d_in[15];
    a.conv_w_out = (const float*)d_in[16]; a.router_w = (const float*)d_in[17]; a.router_b = (const float*)d_in[18]; a.exp_w1 = (const float*)d_in[19]; a.exp_w3 = (const float*)d_in[20];
    a.exp_w2 = (const float*)d_in[21];
    a.out = (float*)d_out; a.ws = (unsigned char*)d_ws;
    hipLaunchKernelGGL(hybrid_fwd, dim3(grid), dim3(512), LDS_BYTES, stream, a);
    const hipError_t le = hipPeekAtLastError();
    if (le != hipSuccess) fprintf(stderr, "kernel_launch: launch failed: %s\n", hipGetErrorName(le));
}
```
